# Optimizing an MI355X kernel written in HIP

```python
import jax, jax.numpy as jnp
from jax import lax
import numpy as np

D_MODEL = 1024
BATCH = 8
SEQ = 2048
DEPTH = 1
DEC_BATCH = 128
DEC_SEQ = 8
PAST_LEN = 8192
PAGE_SIZE = 128

HEAD_DIM = 64
ATT_HEADS = 8
ATT_W = ATT_HEADS * HEAD_DIM
RWKV_HEADS = 8
RWKV_W = RWKV_HEADS * HEAD_DIM
MIX_W = ATT_W + RWKV_W
DIL_BRANCHES = ((128, 1), (512, 4), (2048, 16))
MAX_WINDOW = 2048
ROT_DIM = HEAD_DIM // 4
ROPE_THETA = 500000.0
DECAY_LORA = 64
AAA_LORA = 64
GATE_LORA = 128
RWKV_IN = 3 * RWKV_W + DECAY_LORA + AAA_LORA + GATE_LORA
IN_W = 3 * ATT_W + RWKV_IN
D_FF = 4 * D_MODEL
NORM_EPS = 1e-6
LNX_EPS = 64e-5

kernel_name = 'hybrid_dilated_attn_rwkv7_step'


def rms_norm(x, g):
    xf = x.astype(jnp.float32)
    return xf * lax.rsqrt(jnp.mean(xf * xf, axis=-1, keepdims=True) + NORM_EPS) * g.astype(jnp.float32)


def ada_modulation(c, w_ada, b_ada):
    m = jax.nn.silu(c.astype(jnp.float32)) @ w_ada.astype(jnp.float32) + b_ada.astype(jnp.float32)
    return jnp.split(m[:, None, :], 6, axis=-1)


def partial_rope(t, pos):
    half = ROT_DIM // 2
    inv = ROPE_THETA ** (-jnp.arange(half, dtype=jnp.float32) * (2.0 / ROT_DIM))
    ang = pos.astype(jnp.float32)[:, None] * inv[None, :]
    cos = jnp.cos(ang)[None, :, None, :]
    sin = jnp.sin(ang)[None, :, None, :]
    t = t.astype(jnp.float32)
    t1, t2, rest = t[..., :half], t[..., half:ROT_DIM], t[..., ROT_DIM:]
    return jnp.concatenate([t1 * cos - t2 * sin, t1 * sin + t2 * cos, rest], axis=-1)


def dilated_branch_prompt(q, k, v, window, dil):
    B, S, H, E = q.shape
    nw = window // dil
    span = dil * nw
    Sp = -(-S // span) * span
    pad = ((0, 0), (0, Sp - S), (0, 0), (0, 0))
    n = Sp // dil
    nb = n // nw

    def to_blocks(t):
        t = jnp.pad(t, pad).reshape(B, n, dil, H, E).transpose(0, 2, 1, 3, 4)
        return t.reshape(B, dil, nb, nw, H, E)

    def with_prev(t):
        prev = jnp.pad(t, ((0, 0), (0, 0), (1, 0), (0, 0), (0, 0), (0, 0)))[:, :, :-1]
        return jnp.concatenate([prev, t], axis=3)

    qb = to_blocks(q)
    k2 = with_prev(to_blocks(k))
    v2 = with_prev(to_blocks(v))
    s = jnp.einsum('brnqhe,brnkhe->brnhqk', qb, k2.astype(jnp.float32)) * (HEAD_DIM ** -0.5)
    a_idx = jnp.arange(nw)[:, None]
    c_idx = jnp.arange(2 * nw)[None, :]
    dist = nw + a_idx - c_idx
    band = (dist >= 0) & (dist <= nw)
    has_prev = (jnp.arange(nb) > 0)[:, None, None] | (c_idx >= nw)[None]
    mask = (band[None] & has_prev)[None, None, :, None]
    s = jnp.where(mask, s, -jnp.inf)
    lse = jax.nn.logsumexp(s, axis=-1)
    p = jnp.exp(s - lse[..., None])
    o = jnp.einsum('brnhqk,brnkhe->brnqhe', p, v2.astype(jnp.float32))
    o = o.reshape(B, dil, n, H, E).transpose(0, 2, 1, 3, 4).reshape(B, Sp, H, E)[:, :S]
    lse = lse.transpose(0, 1, 2, 4, 3).reshape(B, dil, n, H).transpose(0, 2, 1, 3).reshape(B, Sp, H)[:, :S]
    return o, lse


def dilated_branch_sample(q, k, v, k_buf, v_buf, window, dil):
    T = q.shape[1]
    WB = k_buf.shape[1]
    nw = window // dil
    scale = HEAD_DIM ** -0.5
    i = jnp.arange(T)
    rel = i[:, None] - dil * jnp.arange(nw + 1)[None, :]
    buf_idx = WB + rel
    buf_ok = (rel < 0) & (buf_idx >= 0)
    buf_idx = jnp.clip(buf_idx, 0, WB - 1)
    kg = k_buf[:, buf_idx].astype(jnp.float32)
    vg = v_buf[:, buf_idx].astype(jnp.float32)
    s_buf = jnp.einsum('bthe,btjhe->bhtj', q, kg) * scale
    s_buf = jnp.where(buf_ok[None, None], s_buf, -jnp.inf)
    diff = i[:, None] - i[None, :]
    new_ok = (diff >= 0) & (diff % dil == 0) & (diff <= window)
    s_new = jnp.einsum('bthe,bshe->bhts', q, k.astype(jnp.float32)) * scale
    s_new = jnp.where(new_ok[None, None], s_new, -jnp.inf)
    s = jnp.concatenate([s_buf, s_new], axis=-1)
    lse = jax.nn.logsumexp(s, axis=-1)
    p = jnp.exp(s - lse[..., None])
    o = (jnp.einsum('bhtj,btjhe->bthe', p[..., :nw + 1], vg)
         + jnp.einsum('bhts,bshe->bthe', p[..., nw + 1:], v.astype(jnp.float32)))
    return o, lse.transpose(0, 2, 1)


def combine_dilations(branches):
    o = jnp.stack([b[0] for b in branches])
    lse = jnp.stack([b[1] for b in branches])
    wts = jax.nn.softmax(lse, axis=0)
    return jnp.sum(wts[..., None] * o, axis=0)


def rwkv7_inputs(P, P_prev, mu, w0, w2, a0, a2, g2, k_k, k_a):
    Pm = P + (P_prev - P) * mu.astype(jnp.float32)
    cuts = [RWKV_W, 2 * RWKV_W, 3 * RWKV_W, 3 * RWKV_W + DECAY_LORA, 3 * RWKV_W + DECAY_LORA + AAA_LORA]
    r, k, v, wl, al, gl = jnp.split(Pm, cuts, axis=-1)
    w = -jax.nn.softplus(-(w0 + jnp.tanh(wl) @ w2)) - 0.5
    decay = jnp.exp(-jnp.exp(w))
    a = jax.nn.sigmoid(a0 + al @ a2)
    g = jax.nn.sigmoid(gl) @ g2
    B, T = P.shape[:2]
    heads = lambda t: t.reshape(B, T, RWKV_HEADS, HEAD_DIM)
    kk = heads(k * k_k)
    kk = kk / jnp.maximum(jnp.sqrt(jnp.sum(kk * kk, axis=-1, keepdims=True)), 1e-12)
    k = k * (1.0 + (a - 1.0) * k_a)
    return heads(r), heads(decay), heads(k), heads(v), kk, heads(a), g


def wkv7_scan(S0, r, w, k, v, kk, a):
    def step(S, inp):
        r_t, w_t, k_t, v_t, kk_t, a_t = inp
        sa = jnp.einsum('bhij,bhj->bhi', S, -kk_t)
        S = (S * w_t[:, :, None, :] + sa[..., None] * (kk_t * a_t)[:, :, None, :]
             + v_t[..., None] * k_t[:, :, None, :])
        return S, jnp.einsum('bhij,bhj->bhi', S, r_t)
    xs = tuple(jnp.swapaxes(t, 0, 1) for t in (r, w, k, v, kk, a))
    S, out = lax.scan(step, S0.astype(jnp.float32), xs)
    return jnp.swapaxes(out, 0, 1), S


def rwkv7_output(o, r, k, v, g, r_k, lnx_g, lnx_b):
    B, T = o.shape[:2]
    mean = jnp.mean(o, axis=-1, keepdims=True)
    var = jnp.mean(jnp.square(o - mean), axis=-1, keepdims=True)
    on = ((o - mean) * lax.rsqrt(var + LNX_EPS)).reshape(B, T, RWKV_W) * lnx_g + lnx_b
    bonus = jnp.sum(r * k * r_k, axis=-1, keepdims=True) * v
    return (on + bonus.reshape(B, T, RWKV_W)) * g


def decoder_layer(x, c, pos, k_past, v_past, wkv0, shift0, norm1_g, norm2_g, w_ada, b_ada, w_in, w_out,
                  mu, w0, w2, a0, a2, g2, k_k, k_a, r_k, lnx_g, lnx_b, w_ff1, w_ff2):
    sh1, sc1, gt1, sh2, sc2, gt2 = ada_modulation(c, w_ada, b_ada)
    h = rms_norm(x, norm1_g) * (1.0 + sc1) + sh1
    proj = h @ w_in
    B, T = proj.shape[:2]
    q, k, v = jnp.split(proj[..., :3 * ATT_W], 3, axis=-1)
    q = partial_rope(q.reshape(B, T, ATT_HEADS, HEAD_DIM), pos)
    k = partial_rope(k.reshape(B, T, ATT_HEADS, HEAD_DIM), pos)
    v = v.reshape(B, T, ATT_HEADS, HEAD_DIM)
    if k_past is None:
        branches = [dilated_branch_prompt(q, k, v, win, dil) for win, dil in DIL_BRANCHES]
        keep = min(MAX_WINDOW, T)
        k_state, v_state = k[:, T - keep:], v[:, T - keep:]
    else:
        branches = [dilated_branch_sample(q, k, v, k_past, v_past, win, dil) for win, dil in DIL_BRANCHES]
        k_state, v_state = k, v
    att = combine_dilations(branches).reshape(B, T, ATT_W)
    P = proj[..., 3 * ATT_W:].astype(jnp.float32)
    P_prev = jnp.concatenate([shift0[:, None, :].astype(jnp.float32), P[:, :-1]], axis=1)
    r, decay, kr, vr, kk, a, g = rwkv7_inputs(P, P_prev, mu, w0, w2, a0, a2, g2, k_k, k_a)
    o, S = wkv7_scan(wkv0, r, decay, kr, vr, kk, a)
    rw = rwkv7_output(o, r, kr, vr, g, r_k, lnx_g, lnx_b)
    mix = jnp.concatenate([att, rw], axis=-1) @ w_out
    x = x + gt1 * mix
    h2 = rms_norm(x, norm2_g) * (1.0 + sc2) + sh2
    x = x + gt2 * (jnp.square(jax.nn.relu(h2 @ w_ff1)) @ w_ff2)
    return x, k_state, v_state, S, P[:, -1]


def setup_inputs(seed: int = 0) -> dict:
    key = jax.random.key(seed)
    ks = jax.random.split(key, 32)
    f32 = jnp.float32
    nrm = lambda kk, shape, s: jax.random.normal(kk, shape, f32) * s
    WB = min(MAX_WINDOW, PAST_LEN)
    return {
        'x_prompt': nrm(ks[0], (BATCH, SEQ, D_MODEL), 1.0),
        'x_sample': nrm(ks[1], (DEC_BATCH, DEC_SEQ, D_MODEL), 1.0),
        'cache_k': nrm(ks[2], (DEPTH, DEC_BATCH, WB, ATT_HEADS, HEAD_DIM), 1.0),
        'cache_v': nrm(ks[3], (DEPTH, DEC_BATCH, WB, ATT_HEADS, HEAD_DIM), 1.0),
        'state_wkv': nrm(ks[4], (DEPTH, DEC_BATCH, RWKV_HEADS, HEAD_DIM, HEAD_DIM), 0.3),
        'state_shift': nrm(ks[5], (DEPTH, DEC_BATCH, RWKV_IN), 1.0),
        'c_prompt': nrm(ks[6], (BATCH, D_MODEL), 1.0),
        'c_sample': nrm(ks[7], (DEC_BATCH, D_MODEL), 1.0),
        'norm1_g': 1.0 + nrm(ks[8], (DEPTH, D_MODEL), 0.05),
        'norm2_g': 1.0 + nrm(ks[9], (DEPTH, D_MODEL), 0.05),
        'w_ada': nrm(ks[10], (DEPTH, D_MODEL, 6 * D_MODEL), 0.5 * D_MODEL ** -0.5),
        'b_ada': nrm(ks[11], (DEPTH, 6 * D_MODEL), 0.02),
        'w_in': nrm(ks[12], (DEPTH, D_MODEL, IN_W), D_MODEL ** -0.5),
        'w_out': nrm(ks[13], (DEPTH, MIX_W, D_MODEL), MIX_W ** -0.5),
        'mu': jax.random.uniform(ks[14], (DEPTH, RWKV_IN), f32),
        'w0': jax.random.uniform(ks[15], (DEPTH, RWKV_W), f32, -4.0, 1.0),
        'w2': nrm(ks[16], (DEPTH, DECAY_LORA, RWKV_W), 0.5 * DECAY_LORA ** -0.5),
        'a0': nrm(ks[17], (DEPTH, RWKV_W), 0.5),
        'a2': nrm(ks[18], (DEPTH, AAA_LORA, RWKV_W), 0.5 * AAA_LORA ** -0.5),
        'g2': nrm(ks[19], (DEPTH, GATE_LORA, RWKV_W), GATE_LORA ** -0.5),
        'k_k': 0.85 + nrm(ks[20], (DEPTH, RWKV_W), 0.1),
        'k_a': 1.0 + nrm(ks[21], (DEPTH, RWKV_W), 0.1),
        'r_k': nrm(ks[22], (DEPTH, RWKV_HEADS, HEAD_DIM), 0.1),
        'lnx_g': 1.0 + nrm(ks[23], (DEPTH, RWKV_W), 0.05),
        'lnx_b': nrm(ks[24], (DEPTH, RWKV_W), 0.02),
        'w_ff1': nrm(ks[25], (DEPTH, D_MODEL, D_FF), D_MODEL ** -0.5),
        'w_ff2': nrm(ks[26], (DEPTH, D_FF, D_MODEL), D_FF ** -0.5),
        'normf_g': 1.0 + nrm(ks[27], (D_MODEL,), 0.05),
    }


def reference(x_prompt, x_sample, cache_k, cache_v, state_wkv, state_shift, c_prompt, c_sample,
              norm1_g, norm2_g, w_ada, b_ada, w_in, w_out, mu, w0, w2, a0, a2, g2, k_k, k_a, r_k,
              lnx_g, lnx_b, w_ff1, w_ff2, normf_g):
    B, S = x_prompt.shape[:2]
    DB, T = x_sample.shape[:2]
    pos_p = jnp.arange(S)
    pos_s = PAST_LEN + jnp.arange(T)
    wkv_zero = jnp.zeros((B, RWKV_HEADS, HEAD_DIM, HEAD_DIM), jnp.float32)
    shift_zero = jnp.zeros((B, RWKV_IN), jnp.float32)
    hp, hs = x_prompt, x_sample
    kp_l, vp_l, sp_l, shp_l, ks_l, vs_l, ss_l, shs_l = [], [], [], [], [], [], [], []
    for l in range(DEPTH):
        lw = (norm1_g[l], norm2_g[l], w_ada[l], b_ada[l], w_in[l], w_out[l], mu[l], w0[l], w2[l],
              a0[l], a2[l], g2[l], k_k[l], k_a[l], r_k[l], lnx_g[l], lnx_b[l], w_ff1[l], w_ff2[l])
        hp, kp, vp, sp, shp = decoder_layer(hp, c_prompt, pos_p, None, None, wkv_zero, shift_zero, *lw)
        hs, kn, vn, sn, shn = decoder_layer(hs, c_sample, pos_s, cache_k[l], cache_v[l],
                                            state_wkv[l], state_shift[l], *lw)
        kp_l.append(kp); vp_l.append(vp); sp_l.append(sp); shp_l.append(shp)
        ks_l.append(kn); vs_l.append(vn); ss_l.append(sn); shs_l.append(shn)
    dt = x_prompt.dtype
    y_prompt = rms_norm(hp, normf_g).astype(dt)
    y_sample = rms_norm(hs, normf_g).astype(x_sample.dtype)
    return (y_prompt, y_sample,
            jnp.stack(kp_l).astype(dt), jnp.stack(vp_l).astype(dt),
            jnp.stack(sp_l).astype(dt), jnp.stack(shp_l).astype(dt),
            jnp.stack(ks_l).astype(dt), jnp.stack(vs_l).astype(dt),
            jnp.stack(ss_l).astype(dt), jnp.stack(shs_l).astype(dt))
```

```cpp
#include <hip/hip_runtime.h>
#include <cstdio>
#include <cstdint>
#include <cmath>
namespace pg8 {
#define PG8_LAS __attribute__((address_space(3)))
typedef unsigned short bf16_t;
typedef short bf16x8 __attribute__((ext_vector_type(8)));
typedef float f32x4 __attribute__((ext_vector_type(4)));
typedef unsigned u32x4 __attribute__((ext_vector_type(4)));
constexpr int BM = 256, BK = 64, HALF = 128, HTB = HALF * BK * 2  , STAGE_BYTES = 8 * HTB, NXCD = 8, WGM = 8;

__host__ __device__ __forceinline__ int lds_byte(int r, int c) { const int st = (r >> 4) * 2 + (c >> 5), rr = r & 15, cc = c & 31, ob = rr * 64 + cc * 2; return st * 1024 + (ob ^ (((ob >> 9) & 1) << 5)); }
__host__ __device__ __forceinline__ void stage_rc(int b, int& R, int& C) { const int st = b / 1024, sb = b % 1024, swz = sb ^ (((sb >> 9) & 1) << 5); R = (st >> 1) * 16 + swz / 64; C = (st & 1) * 32 + (swz % 64) / 2; }
__host__ __device__ __forceinline__ int perm32(int rho) { const int n = rho >> 4, i = rho & 15; return 8 * (i >> 2) + 4 * n + (i & 3); }

struct Unit { int pm, pn; };
struct Gemm { const bf16_t* A; const bf16_t* Bt; int M, N, K; };

struct StaticOrder {
    int nM, nN, nwg, G, c;
    __host__ __device__ void init(int M, int N, int G_, int c_) { nM = M / BM; nN = N / BM; nwg = nM * nN; G = G_; c = c_; }
    __host__ __device__ bool next(int i, Unit& u) const {
        const long L = (long)i * G + c; if (L >= nwg) return false;
        int wgid = (int)L; { const int q = nwg / NXCD, r = nwg % NXCD, xcd = wgid % NXCD, off = wgid / NXCD; wgid = (xcd < r ? xcd * (q + 1) : r * (q + 1) + (xcd - r) * q) + off; }
        const int nig = WGM * nN, gid = wgid / nig, fm = gid * WGM, gsz = (nM - fm) < WGM ? (nM - fm) : WGM;
        u.pm = fm + ((wgid % nig) % gsz); u.pn = (wgid % nig) / gsz; return true;
    }
    __device__ __forceinline__ void a_ready(const Unit&) const {}
    __device__ __forceinline__ void done(const Unit&) const {}
};

typedef float f32x2 __attribute__((ext_vector_type(2)));
typedef __bf16 bf16x2_t __attribute__((ext_vector_type(2)));
__device__ __forceinline__ unsigned cvt_pk_bf16(float lo, float hi) { f32x2 v = {lo, hi}; bf16x2_t b = __builtin_convertvector(v, bf16x2_t); return __builtin_bit_cast(unsigned, b); }

constexpr int E_NP = 16384;
__device__ __forceinline__ int e_modrow(int m) { return m < E_NP ? (m >> 11) : 8 + ((m - E_NP) >> 3); }

struct EpiAda {
    static constexpr bool PERM = false, AFTER_DRAIN = false;
    float* out; int ldc; const float* bias;
    __device__ __forceinline__ void operator()(const f32x4 (&acc)[2][2][4][2], const Unit& u, int wr, int wc, int fr, int fq) const {
        const int row0 = u.pm * BM + wr * 64 + fr, col0 = u.pn * BM + wc * 32 + 4 * fq;
#pragma unroll
        for (int ai = 0; ai < 2; ++ai)
#pragma unroll
            for (int m = 0; m < 4; ++m) { float* rowp = out + (size_t)(row0 + ai * HALF + m * 16) * ldc + col0;
#pragma unroll
                for (int bj = 0; bj < 2; ++bj)
#pragma unroll
                    for (int n = 0; n < 2; ++n) { const f32x4 bv = *(const f32x4*)(bias + col0 + bj * HALF + n * 16); *(f32x4*)(rowp + bj * HALF + n * 16) = acc[ai][bj][m][n] + bv; } }
    }
};
struct EpiRes {
    static constexpr bool PERM = false, AFTER_DRAIN = false;
    const float* base0; const float* base1; int split; float* out; int ldc; const float* gate; int gate_ld;
    __device__ __forceinline__ void operator()(const f32x4 (&acc)[2][2][4][2], const Unit& u, int wr, int wc, int fr, int fq) const {
        const int row0 = u.pm * BM + wr * 64 + fr, col0 = u.pn * BM + wc * 32 + 4 * fq;
#pragma unroll
        for (int ai = 0; ai < 2; ++ai)
#pragma unroll
            for (int m = 0; m < 4; ++m) { const int row = row0 + ai * HALF + m * 16;
                const float* bp = (row < split ? base0 + (size_t)row * ldc : base1 + (size_t)(row - split) * ldc) + col0;
                const float* gp = gate + (size_t)e_modrow(row) * gate_ld + col0; float* rowp = out + (size_t)row * ldc + col0;
#pragma unroll
                for (int bj = 0; bj < 2; ++bj)
#pragma unroll
                    for (int n = 0; n < 2; ++n) { const int o = bj * HALF + n * 16; const f32x4 bs = *(const f32x4*)(bp + o), g = *(const f32x4*)(gp + o); *(f32x4*)(rowp + o) = bs + g * acc[ai][bj][m][n]; } }
    }
};
struct EpiRelu2 {
    static constexpr bool PERM = true, AFTER_DRAIN = false;
    bf16_t* O; int ldc;
    __device__ __forceinline__ void operator()(const f32x4 (&acc)[2][2][4][2], const Unit& u, int wr, int wc, int fr, int fq) const {
        const int row0 = u.pm * BM + wr * 64 + fr, col0 = u.pn * BM + wc * 32 + 8 * fq;
#pragma unroll
        for (int ai = 0; ai < 2; ++ai)
#pragma unroll
            for (int m = 0; m < 4; ++m) { bf16_t* rowp = O + (size_t)(row0 + ai * HALF + m * 16) * ldc + col0;
#pragma unroll
                for (int bj = 0; bj < 2; ++bj) { f32x4 v0 = acc[ai][bj][m][0], v1 = acc[ai][bj][m][1];
                    v0 = __builtin_elementwise_max(v0, (f32x4){0.f, 0.f, 0.f, 0.f}); v1 = __builtin_elementwise_max(v1, (f32x4){0.f, 0.f, 0.f, 0.f}); v0 = v0 * v0; v1 = v1 * v1;
                    u32x4 w; w.x = cvt_pk_bf16(v0[0], v0[1]); w.y = cvt_pk_bf16(v0[2], v0[3]); w.z = cvt_pk_bf16(v1[0], v1[1]); w.w = cvt_pk_bf16(v1[2], v1[3]);
                    *(u32x4*)(rowp + bj * HALF) = w; } }
    }
};
struct EpiProj {
    static constexpr bool PERM = true, AFTER_DRAIN = false;
    bf16_t* QKV; size_t qkv_stride; float* P; const float* rope;
    float* outp; size_t o_kp, o_kv_step_p, o_ks, o_kv_step_s; float *shift_p, *shift_s; float c2;
    __device__ __forceinline__ void operator()(const f32x4 (&acc)[2][2][4][2], const Unit& u, int wr, int wc, int fr, int fq) const {
        const int row0 = u.pm * BM + wr * 64 + fr, pn = u.pn;
        const int lcol = wc * 32 + 8 * fq;
        if (pn < 6) {
            const int kind = pn >> 1;
            const int c0 = (pn & 1) * 256 + lcol;
            const bool dorope = (kind < 2) && ((wc & 1) == 0);
#pragma unroll
            for (int ai = 0; ai < 2; ++ai)
#pragma unroll
                for (int m = 0; m < 4; ++m) { const int row = row0 + ai * HALF + m * 16;
                    f32x4 cs0 = {1.f, 1.f, 1.f, 1.f}, cs1 = cs0, sn0 = {0.f, 0.f, 0.f, 0.f}, sn1 = sn0;
                    if (dorope) { const int ridx = row < E_NP ? (row & 2047) : 2048 + ((row - E_NP) & 7); const float* rp = rope + (size_t)ridx * 16;
                        cs0 = *(const f32x4*)(rp); cs1 = *(const f32x4*)(rp + 4); sn0 = *(const f32x4*)(rp + 8); sn1 = *(const f32x4*)(rp + 12); }
#pragma unroll
                    for (int bj = 0; bj < 2; ++bj) { f32x4 v0 = acc[ai][bj][m][0], v1 = acc[ai][bj][m][1];
                        if (dorope) {
                            f32x4 p0, p1;
#pragma unroll
                            for (int e = 0; e < 4; ++e) { p0[e] = __shfl_xor(v0[e], 16); p1[e] = __shfl_xor(v1[e], 16); }
                            if (fq == 0) { v0 = v0 * cs0 - p0 * sn0; v1 = v1 * cs1 - p1 * sn1; }
                            else if (fq == 1) { v0 = p0 * sn0 + v0 * cs0; v1 = p1 * sn1 + v1 * cs1; }
                        }
                        const int c = c0 + bj * HALF;
                        if (kind >= 1) { float* fo = outp + (row < E_NP ? o_kp + (size_t)(kind - 1) * o_kv_step_p + (size_t)row * 512 : o_ks + (size_t)(kind - 1) * o_kv_step_s + (size_t)(row - E_NP) * 512);
                            *(f32x4*)(fo + c) = v0; *(f32x4*)(fo + c + 4) = v1; }
                        if (kind == 0) { v0 = v0 * c2; v1 = v1 * c2; }
                        u32x4 w; w.x = cvt_pk_bf16(v0[0], v0[1]); w.y = cvt_pk_bf16(v0[2], v0[3]); w.z = cvt_pk_bf16(v1[0], v1[1]); w.w = cvt_pk_bf16(v1[2], v1[3]);
                        bf16_t* bo = QKV + (size_t)kind * qkv_stride + (size_t)row * 512 + c;
                        *(u32x4*)bo = w; } }
        } else {
            const int c0 = (pn - 6) * 256 + lcol;
#pragma unroll
            for (int ai = 0; ai < 2; ++ai)
#pragma unroll
                for (int m = 0; m < 4; ++m) { const int row = row0 + ai * HALF + m * 16; float* po = P + (size_t)row * 1792 + c0;
                    float* so = nullptr;
                    if (row < E_NP) { if ((row & 2047) == 2047) so = shift_p + (size_t)(row >> 11) * 1792 + c0; }
                    else { const int ms = row - E_NP; if ((ms & 7) == 7) so = shift_s + (size_t)(ms >> 3) * 1792 + c0; }
#pragma unroll
                    for (int bj = 0; bj < 2; ++bj) { const f32x4 v0 = acc[ai][bj][m][0], v1 = acc[ai][bj][m][1];
                        *(f32x4*)(po + bj * HALF) = v0; *(f32x4*)(po + bj * HALF + 4) = v1;
                        if (so) { *(f32x4*)(so + bj * HALF) = v0; *(f32x4*)(so + bj * HALF + 4) = v1; } } }
        }
    }
};

template <class Epi, class Sched, bool ALIGN_EPI = false, bool SP2 = false>
__device__ __forceinline__ void gemm_phase(PG8_LAS unsigned char* lds, const Gemm g, const Sched& S, const Epi& E) {
    int tid_ = threadIdx.x; asm volatile("" : "+v"(tid_));
    const int tid = tid_, wid = __builtin_amdgcn_readfirstlane(tid >> 6), lane = tid & 63, wr = wid >> 2, wc = wid & 3, fr = lane & 15, fq = lane >> 4;
    const int K = g.K, nt = K / BK;
    unsigned voffA[2], voffB[2];
#pragma unroll
    for (int i = 0; i < 2; ++i) { int R, C; stage_rc(tid * 16 + i * 8192, R, C); const int Rb = Epi::PERM ? ((R & ~31) + perm32(R & 31)) : R;
        voffA[i] = (unsigned)(R * K + C) * 2u; voffB[i] = (unsigned)(Rb * K + C) * 2u; }
    const size_t kstep = (size_t)(BK * 2);
    const size_t hstep = (size_t)HALF * K * 2;
    const size_t tstep = 2 * hstep;
    const unsigned ldsw = (unsigned)wid * 1024u;
    const int aoff = lds_byte(wr * 64 + fr, fq * 8), boff = lds_byte(wc * 32 + fr, fq * 8);
#define PG8_SA(b, h) (((b) * 2 + (h)) * HTB)
#define PG8_SB(b, h) ((4 + (b) * 2 + (h)) * HTB)
#define PG8_STAGE(bufoff, gbase, voff) do { _Pragma("unroll") for (int _i = 0; _i < 2; ++_i) \
        __builtin_amdgcn_global_load_lds((const unsigned*)((const char*)(gbase) + (voff)[_i]), (PG8_LAS unsigned*)(lds + (bufoff) + ldsw + _i * 8192), 16, 0, 0); } while (0)
#define PG8_LDA(dst, b, h) do { _Pragma("unroll") for (int m = 0; m < 4; ++m) _Pragma("unroll") for (int k = 0; k < 2; ++k) dst[m][k] = *(const PG8_LAS bf16x8*)(lds + PG8_SA(b, h) + aoff + m * 2048 + k * 1024); } while (0)
#define PG8_LDB(dst, b, h) do { _Pragma("unroll") for (int n = 0; n < 2; ++n) _Pragma("unroll") for (int k = 0; k < 2; ++k) dst[n][k] = *(const PG8_LAS bf16x8*)(lds + PG8_SB(b, h) + boff + n * 2048 + k * 1024); } while (0)
#define PG8_MMA(ai, bj, At, Bt) do { __builtin_amdgcn_s_setprio(1); _Pragma("unroll") for (int m = 0; m < 4; ++m) _Pragma("unroll") for (int n = 0; n < 2; ++n) _Pragma("unroll") for (int k = 0; k < 2; ++k) \
        acc[ai][bj][m][n] = __builtin_amdgcn_mfma_f32_16x16x32_bf16(Bt[n][k], At[m][k], acc[ai][bj][m][n], 0, 0, 0); __builtin_amdgcn_s_setprio(0); } while (0)
#define PG8_WAIT_V(n) asm volatile("s_waitcnt vmcnt(" #n ")" ::: "memory")
#define PG8_WAIT_L(n) asm volatile("s_waitcnt lgkmcnt(" #n ")" ::: "memory")
#define PG8_BAR __builtin_amdgcn_s_barrier()
#define PG8_SCHED __builtin_amdgcn_sched_barrier(0)
    Unit cur, nxt; int ui = 0;
    if (!S.next(0, cur)) return;
    f32x4 acc[2][2][4][2];
#pragma unroll
    for (int a = 0; a < 2; ++a)
#pragma unroll
        for (int b = 0; b < 2; ++b)
#pragma unroll
            for (int m = 0; m < 4; ++m)
#pragma unroll
                for (int n = 0; n < 2; ++n) acc[a][b][m][n] = (f32x4){0.f, 0.f, 0.f, 0.f};
    bf16x8 At[4][2], B0[2][2], B1[2][2];
    const char* cA = (const char*)g.A + (size_t)cur.pm * tstep; const char* cB = (const char*)g.Bt + (size_t)cur.pn * tstep;
    S.a_ready(cur);
    if constexpr (SP2) {
        PG8_STAGE(PG8_SB(0, 0), cB, voffB); PG8_STAGE(PG8_SB(0, 1), cB + hstep, voffB); PG8_STAGE(PG8_SA(0, 0), cA, voffA); PG8_STAGE(PG8_SA(0, 1), cA + hstep, voffA);
        if (wr == 1) PG8_BAR;
        PG8_WAIT_V(2); PG8_BAR;
        PG8_STAGE(PG8_SB(1, 0), cB + kstep, voffB); PG8_STAGE(PG8_SA(1, 0), cA + kstep, voffA); PG8_STAGE(PG8_SB(1, 1), cB + hstep + kstep, voffB);
        PG8_WAIT_V(6); PG8_BAR;
    } else {
        PG8_STAGE(PG8_SB(0, 0), cB, voffB); PG8_STAGE(PG8_SA(0, 0), cA, voffA); PG8_STAGE(PG8_SB(0, 1), cB + hstep, voffB); PG8_STAGE(PG8_SA(0, 1), cA + hstep, voffA);
        if (wr == 1) PG8_BAR;
        PG8_WAIT_V(4); PG8_BAR;
        PG8_STAGE(PG8_SB(1, 0), cB + kstep, voffB); PG8_STAGE(PG8_SA(1, 0), cA + kstep, voffA); PG8_STAGE(PG8_SB(1, 1), cB + hstep + kstep, voffB);
        PG8_WAIT_V(6); PG8_BAR;
    }
    for (;;) {
        const bool has_next = S.next(ui + 1, nxt);
        const char* nA = has_next ? (const char*)g.A + (size_t)nxt.pm * tstep : cA; const char* nB = has_next ? (const char*)g.Bt + (size_t)nxt.pn * tstep : cB;
        for (int t = 0; t < nt; t += 2) {
            const bool last = (t == nt - 2);
            const char* a1 = cA + (size_t)(t + 1) * kstep;
            const char* a2 = last ? nA : cA + (size_t)(t + 2) * kstep; const char* b2 = last ? nB : cB + (size_t)(t + 2) * kstep;
            const char* a3 = a2 + kstep; const char* b3 = b2 + kstep;
            if (last && has_next) S.a_ready(nxt);
            if constexpr (SP2) {
            PG8_LDB(B0, 0, 0); PG8_LDB(B1, 0, 1); PG8_SCHED; PG8_LDA(At, 0, 0); PG8_STAGE(PG8_SA(1, 1), a1 + hstep, voffA);
            PG8_WAIT_V(8); PG8_WAIT_L(0); PG8_BAR; PG8_MMA(0, 0, At, B0); PG8_MMA(0, 1, At, B1); PG8_BAR; PG8_SCHED;
            PG8_LDA(At, 0, 1); PG8_STAGE(PG8_SB(0, 0), b2, voffB); PG8_STAGE(PG8_SB(0, 1), b2 + hstep, voffB); PG8_STAGE(PG8_SA(0, 0), a2, voffA);
            PG8_WAIT_V(8); PG8_WAIT_L(0); PG8_BAR; PG8_MMA(1, 0, At, B0); PG8_MMA(1, 1, At, B1); PG8_BAR; PG8_SCHED;
            PG8_LDB(B0, 1, 0); PG8_LDB(B1, 1, 1); PG8_SCHED; PG8_LDA(At, 1, 0); PG8_STAGE(PG8_SA(0, 1), a2 + hstep, voffA);
            PG8_WAIT_V(8); PG8_WAIT_L(0); PG8_BAR; PG8_MMA(0, 0, At, B0); PG8_MMA(0, 1, At, B1); PG8_BAR; PG8_SCHED;
            PG8_LDA(At, 1, 1); PG8_STAGE(PG8_SB(1, 0), b3, voffB); PG8_STAGE(PG8_SB(1, 1), b3 + hstep, voffB); PG8_STAGE(PG8_SA(1, 0), a3, voffA);
            PG8_WAIT_V(8); PG8_WAIT_L(0); PG8_BAR; PG8_MMA(1, 0, At, B0); PG8_MMA(1, 1, At, B1); PG8_BAR; PG8_SCHED;
            } else {
            PG8_LDB(B0, 0, 0); PG8_SCHED; PG8_LDA(At, 0, 0); PG8_STAGE(PG8_SA(1, 1), a1 + hstep, voffA);
            PG8_WAIT_L(8); PG8_BAR; PG8_WAIT_L(0); PG8_MMA(0, 0, At, B0); PG8_BAR; PG8_SCHED;
            PG8_LDB(B1, 0, 1); PG8_STAGE(PG8_SB(0, 0), b2, voffB);
            PG8_BAR; PG8_WAIT_L(0); PG8_MMA(0, 1, At, B1); PG8_BAR;
            PG8_LDA(At, 0, 1); PG8_STAGE(PG8_SA(0, 0), a2, voffA);
            PG8_BAR; PG8_WAIT_L(0); PG8_MMA(1, 0, At, B0); PG8_BAR; PG8_SCHED;
            PG8_STAGE(PG8_SB(0, 1), b2 + hstep, voffB);
            PG8_WAIT_V(6); PG8_BAR; PG8_MMA(1, 1, At, B1); PG8_BAR;
            PG8_LDB(B0, 1, 0); PG8_SCHED; PG8_LDA(At, 1, 0); PG8_STAGE(PG8_SA(0, 1), a2 + hstep, voffA);
            PG8_WAIT_L(8); PG8_BAR; PG8_WAIT_L(0); PG8_MMA(0, 0, At, B0); PG8_BAR; PG8_SCHED;
            PG8_LDB(B1, 1, 1); PG8_STAGE(PG8_SB(1, 0), b3, voffB);
            PG8_BAR; PG8_WAIT_L(0); PG8_MMA(0, 1, At, B1); PG8_BAR;
            PG8_LDA(At, 1, 1); PG8_STAGE(PG8_SA(1, 0), a3, voffA);
            PG8_BAR; PG8_WAIT_L(0); PG8_MMA(1, 0, At, B0); PG8_BAR; PG8_SCHED;
            PG8_STAGE(PG8_SB(1, 1), b3 + hstep, voffB);
            PG8_WAIT_V(6); PG8_BAR; PG8_MMA(1, 1, At, B1); PG8_BAR;
            }
        }
        if constexpr (ALIGN_EPI) { if (wr == 0) PG8_BAR; }
        if constexpr (!Epi::AFTER_DRAIN) { E(acc, cur, wr, wc, fr, fq); S.done(cur); }
        if (!has_next) break;
#pragma unroll
        for (int a = 0; a < 2; ++a)
#pragma unroll
            for (int b = 0; b < 2; ++b)
#pragma unroll
                for (int m = 0; m < 4; ++m)
#pragma unroll
                    for (int n = 0; n < 2; ++n) acc[a][b][m][n] = (f32x4){0.f, 0.f, 0.f, 0.f};
        cur = nxt; cA = nA; cB = nB; ++ui;
        if constexpr (ALIGN_EPI) { if (wr == 1) PG8_BAR; }
    }
    PG8_WAIT_V(0);
    if constexpr (!ALIGN_EPI) { if (wr == 0) PG8_BAR; }
    PG8_BAR;
    if constexpr (Epi::AFTER_DRAIN) { E.fused(acc, cur, wr, wc, fr, fq, lds, wid, lane); S.done(cur); }
#undef PG8_SA
#undef PG8_SB
#undef PG8_STAGE
#undef PG8_LDA
#undef PG8_LDB
#undef PG8_MMA
#undef PG8_WAIT_V
#undef PG8_WAIT_L
#undef PG8_BAR
#undef PG8_SCHED
}
}

#define GAS __attribute__((address_space(1)))
#define LAS __attribute__((address_space(3)))
typedef unsigned short bf16;
typedef unsigned v4u __attribute__((ext_vector_type(4)));
typedef float f32x4 __attribute__((ext_vector_type(4)));
typedef short bf16x8 __attribute__((ext_vector_type(8)));
typedef GAS unsigned gu32;
typedef GAS unsigned long long gu64;
#define RLX_AGENT __ATOMIC_RELAXED, __HIP_MEMORY_SCOPE_AGENT
#define LDS_WAIT() asm volatile("s_waitcnt lgkmcnt(0)" ::: "memory")
#define VM_WAIT() asm volatile("s_waitcnt vmcnt(0)" ::: "memory")
__device__ __forceinline__ unsigned long long rt() { return __builtin_amdgcn_s_memrealtime(); }
__device__ __forceinline__ unsigned f2bf(float f) { unsigned u = __builtin_bit_cast(unsigned, f); return (u + 0x7fffu + ((u >> 16) & 1u)) >> 16; }
__device__ __forceinline__ unsigned pk2(float lo, float hi) { return f2bf(lo) | (f2bf(hi) << 16); }
#define XB_TMO      128
#define XB_XCNT(j)  (256  + 64 * (j))
#define XB_XSUB(j)  (1280 + 64 * (j))
#define XB_XGEN(j)  (2304 + 64 * (j))
#define XB_TOP      3328
#define XB_TOPGEN   3392
#define XCD_BAR_WORDS 3456
#define XB_SPIN_CAP (1u << 18)

__device__ __forceinline__ unsigned xb_ld(unsigned* p)              { return __hip_atomic_load(p, __ATOMIC_RELAXED, __HIP_MEMORY_SCOPE_AGENT); }
__device__ __forceinline__ unsigned xb_add(unsigned* p, unsigned v) { return __hip_atomic_fetch_add(p, v, __ATOMIC_RELAXED, __HIP_MEMORY_SCOPE_AGENT); }
__device__ __forceinline__ unsigned xb_xcc_id() { return (unsigned)__builtin_amdgcn_s_getreg((3 << 11) | 20) & 0xFu; }
#define XB_SPIN(cond, bar) do { unsigned _sp = 0; while (cond) { __builtin_amdgcn_s_sleep(1); \
    if ((++_sp & 255u) == 0u) { if (xb_ld(&(bar)[XB_TMO])) break; if (_sp > XB_SPIN_CAP) { atomicAdd(&(bar)[XB_TMO], 1u); break; } } } } while (0)

struct XcdBarrier {
    unsigned* bar; unsigned x;
    volatile LAS unsigned* st;
};

__device__ __forceinline__ XcdBarrier xcd_barrier_post(unsigned* bar, volatile LAS unsigned* st) {
    XcdBarrier b; b.bar = bar; b.x = xb_xcc_id(); b.st = st;
    if (threadIdx.x == 0) (void)xb_add(&bar[XB_XCNT(b.x)], 1u);
    return b;
}
__device__ __forceinline__ void xcd_barrier_complete(unsigned* bar, unsigned x, unsigned& nloc, unsigned& nx) {
    const unsigned G = gridDim.x * gridDim.y * gridDim.z;
    unsigned sum, cnt, mine, sp = 0u;
    for (;;) {
        sum = 0u; cnt = 0u; mine = 0u;
#pragma unroll
        for (unsigned j = 0; j < 16; ++j) { const unsigned c = xb_ld(&bar[XB_XCNT(j)]); sum += c; cnt += (c > 0u) ? 1u : 0u; mine = (j == x) ? c : mine; }
        if (sum == G) break;
        __builtin_amdgcn_s_sleep(1);
        if ((++sp & 255u) == 0u) { if (xb_ld(&bar[XB_TMO])) break; if (sp > XB_SPIN_CAP) { atomicAdd(&bar[XB_TMO], 1u); break; } }
    }
    nloc = mine > 0u ? mine : 1u; nx = cnt > 0u ? cnt : 1u;
}

__device__ __forceinline__ void xcd_barrier(const XcdBarrier& b) {
    asm volatile("s_waitcnt vmcnt(0)" ::: "memory");
    __syncthreads();
    if (threadIdx.x == 0) {
        unsigned* bar = b.bar;
        __builtin_amdgcn_s_waitcnt(0);
        unsigned nloc = b.st[0], nx = b.st[1];
        if (nloc == 0u) { xcd_barrier_complete(bar, b.x, nloc, nx); b.st[0] = nloc; b.st[1] = nx; }
        const unsigned old = xb_add(&bar[XB_XSUB(b.x)], 1u);
        const unsigned gen = old / nloc;
        if (old + 1u == (gen + 1u) * nloc) {
            __builtin_amdgcn_fence(__ATOMIC_RELEASE, "agent");
            asm volatile("s_waitcnt vmcnt(0)" ::: "memory");
            const unsigned og = xb_add(&bar[XB_TOP], 1u);
            const unsigned tg = og / nx;
            if (og + 1u == (tg + 1u) * nx) xb_add(&bar[XB_TOPGEN], 1u);
            else XB_SPIN(xb_ld(&bar[XB_TOPGEN]) == tg, bar);
            __builtin_amdgcn_fence(__ATOMIC_ACQUIRE, "agent");
            xb_add(&bar[XB_XGEN(b.x)], 1u);
            asm volatile("s_waitcnt vmcnt(0)" ::: "memory");
        } else {
            XB_SPIN(xb_ld(&bar[XB_XGEN(b.x)]) == gen, bar);
            __builtin_amdgcn_fence(__ATOMIC_ACQUIRE, "agent");
            asm volatile("s_waitcnt vmcnt(0)" ::: "memory");
        }
    }
    __syncthreads();
}

__device__ __forceinline__ float wave_sum(float v) {
#pragma unroll
    for (int o = 1; o < 64; o <<= 1) v += __shfl_xor(v, o);
    return v;
}
__device__ __forceinline__ void p0_transpose_item(const float* W, int K, int N, bf16* WT, int row_off, LAS float* scr, int item, int lane) {
    const int nblk = N / 32, kb = item / nblk, nb = item % nblk, k0 = 64 * kb, n0 = 32 * nb;
#pragma unroll 8
    for (int i = 0; i < 32; ++i) { const int kk = 2 * i + (lane >> 5); scr[kk * 33 + (lane & 31)] = W[(size_t)(k0 + kk) * N + n0 + (lane & 31)]; }
    LDS_WAIT(); asm volatile("" ::: "memory");
    const int c = lane & 7;
#pragma unroll
    for (int j = 0; j < 4; ++j) { const int n = (lane >> 3) + 8 * j; const LAS float* s = scr + (8 * c) * 33 + n;
        v4u o; o.x = pk2(s[0 * 33], s[1 * 33]); o.y = pk2(s[2 * 33], s[3 * 33]); o.z = pk2(s[4 * 33], s[5 * 33]); o.w = pk2(s[6 * 33], s[7 * 33]);
        *(GAS v4u*)(WT + (size_t)(row_off + n0 + n) * K + k0 + 8 * c) = o; }
    LDS_WAIT(); asm volatile("" ::: "memory");
}

constexpr int DM = 1024, NP = 16384, NSM = 1024, MT = NP + NSM;
constexpr int SEQ = 2048, NDB = 128, WBUF = 2048;
constexpr int INW = 3328, RIN = 1792, AW = 512, DFF = 4096, HD = 64;
constexpr int MODW = 6144;
constexpr float NORM_EPS = 1e-6f, LNX_EPS = 64e-5f;
constexpr float QC2 = 0.125f * 1.4426950408889634f;
constexpr int NWAVES = 8;

constexpr size_t MiB = 1u << 20;
constexpr size_t WS_CTL = 0, CTL_ZERO_BYTES = 1 * MiB;
constexpr size_t WS_WIN = 2 * MiB, WS_WOUT = 9 * MiB, WS_WFF1 = 11 * MiB, WS_WFF2 = 19 * MiB, WS_WADA = 27 * MiB;
constexpr size_t WS_SILU = 39 * MiB, WS_ROPE = 40 * MiB, WS_LW2 = 41 * MiB, WS_LA2 = 41 * MiB + 65536, WS_LG2 = 41 * MiB + 131072;
constexpr size_t WS_MOD = 42 * MiB, WS_H = 48 * MiB, WS_Q = 82 * MiB, WS_K = 99 * MiB, WS_V = 116 * MiB, WS_P = 133 * MiB;
constexpr size_t WS_DEC = 252 * MiB, WS_KP = 286 * MiB, WS_KK = 320 * MiB, WS_KKA = 354 * MiB, WS_G = 388 * MiB, WS_BON = 422 * MiB;
constexpr size_t WS_SOUT = 423 * MiB, WS_APART = 457 * MiB, WS_LSE = 508 * MiB, WS_MIX = 510 * MiB, WS_X1 = 544 * MiB, WS_U = 612 * MiB, WS_X2 = 748 * MiB, WS_END = 816 * MiB;
constexpr int CW_BAR = 4096;
constexpr size_t ZROW_OFF = 524288;
constexpr size_t O_YP = 0, O_YS = 16777216, O_KP = 17825792, O_VP = 26214400, O_WKVP = 34603008, O_SHP = 34865152, O_KS = 34879488, O_VS = 35403776, O_WKVS = 35928064, O_SHS = 40122368, O_END = 40351744;

constexpr int RING_OFF = 0, RING_BYTES = 131072;
constexpr int LDSCTL_OFF = RING_BYTES, MISC_OFF = LDSCTL_OFF + 320;
constexpr int LDS_BYTES = 147456;

struct KP { const float* in[28]; float* out; unsigned char* ws; };

typedef float f32x16 __attribute__((ext_vector_type(16)));
typedef float f32x2 __attribute__((ext_vector_type(2)));
typedef short s16x4 __attribute__((ext_vector_type(4)));
#define NEG_INF (-__builtin_inff())
#define MFMA32(a, b, c) __builtin_amdgcn_mfma_f32_32x32x16_bf16((a), (b), (c), 0, 0, 0)
__device__ __forceinline__ int crow(int r, int hi) { return (r & 3) + 8 * (r >> 2) + 4 * hi; }
using pg8::cvt_pk_bf16;
__device__ __forceinline__ bf16x8 pack8(float a0, float a1, float a2, float a3, float a4, float a5, float a6, float a7) {
    v4u w; w.x = cvt_pk_bf16(a0, a1); w.y = cvt_pk_bf16(a2, a3); w.z = cvt_pk_bf16(a4, a5); w.w = cvt_pk_bf16(a6, a7); return __builtin_bit_cast(bf16x8, w); }
__device__ __forceinline__ float bf2f(unsigned short b) { return __builtin_bit_cast(float, (unsigned)b << 16); }
template <int CTRL> __device__ __forceinline__ float dpp(float x) { return __builtin_bit_cast(float, __builtin_amdgcn_mov_dpp(__builtin_bit_cast(int, x), CTRL, 0xf, 0xf, true)); }
__device__ __forceinline__ float sum4(float x) { x += dpp<0xB1>(x); x += dpp<0x4E>(x); return x; }
__device__ __forceinline__ float sum8(float x) { x = sum4(x); x += dpp<0x141>(x); return x; }
__device__ __forceinline__ float sum16(float x) { x = sum8(x); x += dpp<0x128>(x); return x; }
__device__ __forceinline__ float sum32(float x) { x = sum16(x); x += __shfl_xor(x, 16); return x; }
__device__ __forceinline__ float sigmoidf_(float x) { return 1.0f / (1.0f + expf(-x)); }
__device__ __forceinline__ int modrow(int m) { return m < NP ? (m >> 11) : 8 + ((m - NP) >> 3); }

__device__ __forceinline__ void p0_prologue(const KP& p, LAS unsigned char* lds, int vcu, int G, int tid) {
    const int wave = __builtin_amdgcn_readfirstlane(tid >> 6), lane = tid & 63;
    LAS float* scr = (LAS float*)(lds + RING_OFF + wave * 16384);
    const int gw = vcu * NWAVES + wave, NGW = G * NWAVES;
    constexpr int I_IN = (DM / 64) * (INW / 32), I_OUT = (DM / 64) * (DM / 32), I_F1 = (DM / 64) * (DFF / 32), I_F2 = (DFF / 64) * (DM / 32), I_ADA = (DM / 64) * (MODW / 32);
    constexpr int NITEMS = I_IN + I_OUT + I_F1 + I_F2 + I_ADA;
    for (int it = gw; it < NITEMS; it += NGW) {
        int r = it;
        if (r < I_IN) { p0_transpose_item(p.in[12], DM, INW, (bf16*)(p.ws + WS_WIN), 0, scr, r, lane); continue; } r -= I_IN;
        if (r < I_OUT) { p0_transpose_item(p.in[13], DM, DM, (bf16*)(p.ws + WS_WOUT), 0, scr, r, lane); continue; } r -= I_OUT;
        if (r < I_F1) { p0_transpose_item(p.in[25], DM, DFF, (bf16*)(p.ws + WS_WFF1), 0, scr, r, lane); continue; } r -= I_F1;
        if (r < I_F2) { p0_transpose_item(p.in[26], DFF, DM, (bf16*)(p.ws + WS_WFF2), 0, scr, r, lane); continue; } r -= I_F2;
        p0_transpose_item(p.in[10], DM, MODW, (bf16*)(p.ws + WS_WADA), 0, scr, r, lane);
    }
    const int gt = vcu * (NWAVES * 64) + tid, NGT = G * NWAVES * 64;
    for (int g = gt; g < 256 * 256; g += NGT) { const int row = g >> 8, c4 = (g & 255) * 4;
        f32x4 c = {0.f, 0.f, 0.f, 0.f};
        if (row < 8) c = *(const f32x4*)(p.in[6] + (size_t)row * DM + c4); else if (row < 136) c = *(const f32x4*)(p.in[7] + (size_t)(row - 8) * DM + c4);
        f32x4 s; for (int e = 0; e < 4; ++e) s[e] = c[e] / (1.0f + expf(-c[e]));
        unsigned long long o = (unsigned long long)cvt_pk_bf16(s[0], s[1]) | ((unsigned long long)cvt_pk_bf16(s[2], s[3]) << 32);
        *(unsigned long long*)((bf16*)(p.ws + WS_SILU) + (size_t)row * DM + c4) = o; }
    for (int e = gt; e < 2056 * 8; e += NGT) { const int idx = e >> 3, i = e & 7; const int pos = idx < 2048 ? idx : 8192 + (idx - 2048);
        const double inv = exp(-(double)i * (0.125 * 13.122363377404328));
        const double ang = (double)pos * inv; const double k = rint(ang * 0.15915494309189535); const float rr = (float)(ang - k * 6.283185307179586);
        float* t = (float*)(p.ws + WS_ROPE) + (size_t)idx * 16; t[i] = cosf(rr); t[8 + i] = sinf(rr); }
    for (int e = gt; e < 16384; e += NGT) {
        const float* W; bf16x8* dst; int KS, r = e;
        if (r < 4096) { W = p.in[16]; dst = (bf16x8*)(p.ws + WS_LW2); KS = 4; } else if (r < 8192) { r -= 4096; W = p.in[18]; dst = (bf16x8*)(p.ws + WS_LA2); KS = 4; } else { r -= 8192; W = p.in[19]; dst = (bf16x8*)(p.ws + WS_LG2); KS = 8; }
        const int ln = r & 63, fk = r >> 6, nt = fk / KS, ks = fk % KS; const int n = 32 * nt + (ln & 31), k0 = 16 * ks + 8 * (ln >> 5);
        float w[8]; for (int j = 0; j < 8; ++j) w[j] = W[(size_t)(k0 + j) * 512 + n];
        dst[r] = pack8(w[0], w[1], w[2], w[3], w[4], w[5], w[6], w[7]); }
}

__device__ __forceinline__ void norm_mod_rows(const float* x0, const float* x1, const float* gain, const float* mod, int sh_off, int sc_off, bf16* H, int vcu, int G, int tid) {
    const int wave = __builtin_amdgcn_readfirstlane(tid >> 6), lane = tid & 63, gw = vcu * NWAVES + wave, NGW = G * NWAVES;
    for (int m = gw; m < MT; m += NGW) {
        const float* xr = m < NP ? x0 + (size_t)m * DM : x1 + (size_t)(m - NP) * DM;
        const GAS f32x4* xv = (const GAS f32x4*)xr + lane;
        f32x4 v[4]; float s = 0.f;
#pragma unroll
        for (int j = 0; j < 4; ++j) { v[j] = xv[64 * j]; s += (v[j].x * v[j].x + v[j].y * v[j].y) + (v[j].z * v[j].z + v[j].w * v[j].w); }
        const float rstd = 1.0f / sqrtf(wave_sum(s) * (1.0f / DM) + NORM_EPS);
        const float* mr = mod + (size_t)modrow(m) * MODW;
        GAS unsigned long long* o8 = (GAS unsigned long long*)(H + (size_t)m * DM) + lane;
#pragma unroll
        for (int j = 0; j < 4; ++j) { const int c = 4 * lane + 256 * j;
            const f32x4 g = *(const f32x4*)(gain + c), sc = *(const f32x4*)(mr + sc_off + c), sh = *(const f32x4*)(mr + sh_off + c);
            const f32x4 o = v[j] * rstd * g * (sc + 1.0f) + sh;
            o8[64 * j] = (unsigned long long)cvt_pk_bf16(o.x, o.y) | ((unsigned long long)cvt_pk_bf16(o.z, o.w) << 32); }
    }
}
__device__ __forceinline__ void final_norm_rows(const float* X, const float* gain, float* out, int vcu, int G, int tid) {
    const int wave = __builtin_amdgcn_readfirstlane(tid >> 6), lane = tid & 63, gw = vcu * NWAVES + wave, NGW = G * NWAVES;
    for (int m = gw; m < MT; m += NGW) {
        const GAS f32x4* xv = (const GAS f32x4*)(X + (size_t)m * DM) + lane;
        f32x4 v[4]; float s = 0.f;
#pragma unroll
        for (int j = 0; j < 4; ++j) { v[j] = xv[64 * j]; s += (v[j].x * v[j].x + v[j].y * v[j].y) + (v[j].z * v[j].z + v[j].w * v[j].w); }
        const float rstd = 1.0f / sqrtf(wave_sum(s) * (1.0f / DM) + NORM_EPS);
        GAS f32x4* ov = (GAS f32x4*)(out + (size_t)m * DM) + lane;
#pragma unroll
        for (int j = 0; j < 4; ++j) { const f32x4 g = *(const f32x4*)(gain + 4 * lane + 256 * j); ov[64 * j] = v[j] * rstd * g; }
    }
}

constexpr int VP = 144;
constexpr int WLDS = 32 * VP + 256;
#define TRR(dst, off) asm volatile("ds_read_b64_tr_b16 %0, %1 offset:%c2" : "=&v"(dst) : "v"(vb), "i"(off) : "memory")
__device__ __forceinline__ void attn_prompt_task(const KP& p, int tk, LAS unsigned char* wl, int lane) {
    const bf16* Q = (const bf16*)(p.ws + WS_Q); const bf16* K = (const bf16*)(p.ws + WS_K); const bf16* V = (const bf16*)(p.ws + WS_V);
    const int bh = tk / 192, rem = tk % 192, unit = rem >> 2, qt = rem & 3, b = bh >> 3, h = bh & 7;
    int br, dil, cls, nb;
    if (unit < 16) { br = 0; dil = 1; cls = 0; nb = unit; } else if (unit < 32) { br = 1; dil = 4; cls = (unit - 16) & 3; nb = (unit - 16) >> 2; } else { br = 2; dil = 16; cls = unit - 32; nb = 0; }
    const int r32 = lane & 31, hi = lane >> 5, m0 = nb * 128 + qt * 32;
    const size_t rowb = (size_t)b * SEQ;
    const int pq = (m0 + r32) * dil + cls;
    bf16x8 qr[4];
    { const bf16* qp = Q + (rowb + pq) * AW + h * HD + hi * 8;
#pragma unroll
      for (int d0 = 0; d0 < 4; ++d0) qr[d0] = *(const bf16x8*)(qp + d0 * 16); }
    const int kt_lo = (nb == 0) ? 4 - qt : 0;
    f32x16 S[5];
#pragma unroll
    for (int kt = 0; kt < 5; ++kt) {
        f32x16 a;
#pragma unroll
        for (int r = 0; r < 16; ++r) a[r] = 0.f;
        if (kt >= kt_lo) {
            const int pk = (m0 - 128 + 32 * kt + r32) * dil + cls;
            const bf16* kp = K + (rowb + pk) * AW + h * HD + hi * 8;
            bf16x8 kf[4];
#pragma unroll
            for (int d0 = 0; d0 < 4; ++d0) kf[d0] = *(const bf16x8*)(kp + d0 * 16);
#pragma unroll
            for (int d0 = 0; d0 < 4; ++d0) a = MFMA32(kf[d0], qr[d0], a);
            if (kt == 0) {
#pragma unroll
                for (int r = 0; r < 16; ++r) if (crow(r, hi) < r32) a[r] = NEG_INF;
            }
            if (kt == 4) {
#pragma unroll
                for (int r = 0; r < 16; ++r) if (crow(r, hi) > r32) a[r] = NEG_INF;
            }
        } else {
#pragma unroll
            for (int r = 0; r < 16; ++r) a[r] = NEG_INF;
        }
        S[kt] = a;
    }
    float mx = NEG_INF;
#pragma unroll
    for (int kt = 0; kt < 5; ++kt)
#pragma unroll
        for (int r = 0; r < 16; ++r) mx = fmaxf(mx, S[kt][r]);
    mx = fmaxf(mx, __shfl_xor(mx, 32));
    float l = 0.f;
#pragma unroll
    for (int kt = 0; kt < 5; ++kt)
#pragma unroll
        for (int r = 0; r < 16; ++r) { const float e = __builtin_amdgcn_exp2f(S[kt][r] - mx); S[kt][r] = e; l += e; }
    l += __shfl_xor(l, 32);
    f32x16 o0, o1;
#pragma unroll
    for (int r = 0; r < 16; ++r) { o0[r] = 0.f; o1[r] = 0.f; }
    const int i16 = lane & 15, q4 = i16 >> 2, p4 = i16 & 3, g16 = (lane >> 4) & 1;
    const unsigned vb = (unsigned)(uintptr_t)wl + (unsigned)((4 * hi + q4) * VP + 32 * g16 + 8 * p4);
#pragma unroll
    for (int kt = 0; kt < 5; ++kt) {
        if (kt >= kt_lo) {
            v4u vv[4];
#pragma unroll
            for (int i = 0; i < 4; ++i) { const int rr = (lane >> 3) + 8 * i, ch = lane & 7; const int pk = (m0 - 128 + 32 * kt + rr) * dil + cls;
                vv[i] = *(const v4u*)(V + (rowb + pk) * AW + h * HD + ch * 8); }
#pragma unroll
            for (int i = 0; i < 4; ++i) { const int rr = (lane >> 3) + 8 * i, ch = lane & 7; *(LAS v4u*)(wl + rr * VP + ch * 16) = vv[i]; }
            const bf16x8 pa0 = pack8(S[kt][0], S[kt][1], S[kt][2], S[kt][3], S[kt][4], S[kt][5], S[kt][6], S[kt][7]);
            const bf16x8 pa1 = pack8(S[kt][8], S[kt][9], S[kt][10], S[kt][11], S[kt][12], S[kt][13], S[kt][14], S[kt][15]);
            s16x4 t00l, t00h, t01l, t01h, t10l, t10h, t11l, t11h;
            asm volatile("s_waitcnt lgkmcnt(0)" ::: "memory");
            TRR(t00l, 0);                 TRR(t00h, 8 * VP);
            TRR(t01l, 64);                TRR(t01h, 8 * VP + 64);
            TRR(t10l, 16 * VP);           TRR(t10h, 24 * VP);
            TRR(t11l, 16 * VP + 64);      TRR(t11h, 24 * VP + 64);
            asm volatile("s_waitcnt lgkmcnt(0)" ::: "memory");
            __builtin_amdgcn_sched_barrier(0);
#define PKV(lo, hi_) (bf16x8){lo[0], lo[1], lo[2], lo[3], hi_[0], hi_[1], hi_[2], hi_[3]}
            o0 = MFMA32(pa0, PKV(t00l, t00h), o0); o1 = MFMA32(pa0, PKV(t01l, t01h), o1);
            o0 = MFMA32(pa1, PKV(t10l, t10h), o0); o1 = MFMA32(pa1, PKV(t11l, t11h), o1);
#undef PKV
        }
    }
    LAS float* ls = (LAS float*)(wl + 32 * VP);
    if (hi == 0) ls[r32] = l;
    asm volatile("s_waitcnt lgkmcnt(0)" ::: "memory");
    float rl[16];
#pragma unroll
    for (int r = 0; r < 16; ++r) rl[r] = 1.0f / ls[crow(r, hi)];
    LAS unsigned short* stg = (LAS unsigned short*)wl;
#pragma unroll
    for (int r = 0; r < 16; ++r) { const int orow = crow(r, hi);
        stg[orow * 64 + r32] = (unsigned short)(cvt_pk_bf16(o0[r] * rl[r], 0.f) & 0xffffu);
        stg[orow * 64 + 32 + r32] = (unsigned short)(cvt_pk_bf16(o1[r] * rl[r], 0.f) & 0xffffu); }
    asm volatile("s_waitcnt lgkmcnt(0)" ::: "memory");
    bf16* AP = (bf16*)(p.ws + WS_APART) + (size_t)br * MT * AW;
#pragma unroll
    for (int i = 0; i < 4; ++i) { const int row = i * 8 + (lane >> 3), ch = lane & 7; const v4u v = *(const LAS v4u*)(stg + row * 64 + ch * 8);
        const int pr = (m0 + row) * dil + cls; *(v4u*)(AP + (rowb + pr) * AW + h * HD + ch * 8) = v; }
    if (hi == 0) { float* L = (float*)(p.ws + WS_LSE) + (size_t)br * MT * 8; L[(rowb + pq) * 8 + h] = mx + __builtin_amdgcn_logf(l); }
    asm volatile("s_waitcnt lgkmcnt(0)" ::: "memory");
}

template <int ACT> __device__ __forceinline__ bf16x8 prep_afrag(const float* pr, const float* pp, const float* mu, int c) {
    float x[8];
#pragma unroll
    for (int q = 0; q < 2; ++q) { const f32x4 a = *(const f32x4*)(pr + c + 4 * q), bq = *(const f32x4*)(pp + c + 4 * q), mq = *(const f32x4*)(mu + c + 4 * q); const f32x4 y = a + (bq - a) * mq;
        x[4 * q] = y.x; x[4 * q + 1] = y.y; x[4 * q + 2] = y.z; x[4 * q + 3] = y.w; }
    if (ACT == 1) {
#pragma unroll
        for (int j = 0; j < 8; ++j) x[j] = tanhf(x[j]); }
    if (ACT == 2) {
#pragma unroll
        for (int j = 0; j < 8; ++j) x[j] = sigmoidf_(x[j]); }
    return pack8(x[0], x[1], x[2], x[3], x[4], x[5], x[6], x[7]);
}
__device__ __forceinline__ const float* prev_row(const KP& p, const float* P, int m) {
    if (m < NP) return (m & 2047) == 0 ? (const float*)(p.ws + WS_CTL + ZROW_OFF) : P + (size_t)(m - 1) * RIN;
    const int ms = m - NP; return (ms & 7) == 0 ? p.in[5] + (size_t)(ms >> 3) * RIN : P + (size_t)(m - 1) * RIN;
}
__device__ __forceinline__ void prep_a_task(const KP& p, int tg, int hp, int lane) {
    const int r32 = lane & 31, hi = lane >> 5;
    const float* P = (const float*)(p.ws + WS_P); const float* mu = p.in[14];
    bf16x8 aa[4];
    { const int m = 32 * tg + r32; const float* pr = P + (size_t)m * RIN; const float* pp = prev_row(p, P, m);
#pragma unroll
      for (int ks = 0; ks < 4; ++ks) aa[ks] = prep_afrag<0>(pr, pp, mu, 1600 + 16 * ks + 8 * hi); }
    const bf16x8* LA2 = (const bf16x8*)(p.ws + WS_LA2);
    float* KPo = (float*)(p.ws + WS_KP); float* KKo = (float*)(p.ws + WS_KK); float* KKAo = (float*)(p.ws + WS_KKA); float* BON = (float*)(p.ws + WS_BON);
    const float* a0 = p.in[17]; const float* k_k = p.in[20]; const float* k_a = p.in[21]; const float* r_k = p.in[22];
#pragma unroll 1
    for (int hh2 = 0; hh2 < 2; ++hh2) {
        const int hh = 2 * hp + hh2, c0 = 64 * hh + r32, c1 = c0 + 32;
        f32x16 d0, d1;
#pragma unroll
        for (int r = 0; r < 16; ++r) { d0[r] = 0.f; d1[r] = 0.f; }
#pragma unroll
        for (int ks = 0; ks < 4; ++ks) { d0 = MFMA32(aa[ks], LA2[((2 * hh) * 4 + ks) * 64 + lane], d0); d1 = MFMA32(aa[ks], LA2[((2 * hh + 1) * 4 + ks) * 64 + lane], d1); }
        const float a00 = a0[c0], a01 = a0[c1], kk0 = k_k[c0], kk1 = k_k[c1], ka0 = k_a[c0], ka1 = k_a[c1], rk0 = r_k[c0], rk1 = r_k[c1];
        const float mk0 = mu[512 + c0], mk1 = mu[512 + c1], mr0 = mu[c0], mr1 = mu[c1];
#pragma unroll
        for (int r = 0; r < 16; ++r) { const int mt = 32 * tg + crow(r, hi); const float* pr = P + (size_t)mt * RIN; const float* pp = prev_row(p, P, mt);
            const float av0 = sigmoidf_(a00 + d0[r]), av1 = sigmoidf_(a01 + d1[r]);
            const float x0 = pr[512 + c0], x1 = pr[512 + c1], kl0 = x0 + (pp[512 + c0] - x0) * mk0, kl1 = x1 + (pp[512 + c1] - x1) * mk1;
            const float y0 = pr[c0], y1 = pr[c1], rl0 = y0 + (pp[c0] - y0) * mr0, rl1 = y1 + (pp[c1] - y1) * mr1;
            const float kp0 = kl0 * (1.0f + (av0 - 1.0f) * ka0), kp1 = kl1 * (1.0f + (av1 - 1.0f) * ka1), kr0 = kl0 * kk0, kr1 = kl1 * kk1;
            const float n2 = sum32(kr0 * kr0 + kr1 * kr1), bn = sum32(rl0 * kp0 * rk0 + rl1 * kp1 * rk1);
            const float rn = 1.0f / fmaxf(sqrtf(n2), 1e-12f); const float kn0 = kr0 * rn, kn1 = kr1 * rn;
            const size_t o = (size_t)mt * AW;
            KPo[o + c0] = kp0; KPo[o + c1] = kp1; KKo[o + c0] = kn0; KKo[o + c1] = kn1; KKAo[o + c0] = kn0 * av0; KKAo[o + c1] = kn1 * av1;
            if (r32 == 0) BON[(size_t)mt * 8 + hh] = bn;
            if ((r & 1) == 1) asm volatile("" ::: "memory");
        }
    }
}
__device__ __forceinline__ void prep_w_task(const KP& p, int tg, int h4, int lane) {
    const int r32 = lane & 31, hi = lane >> 5;
    const float* P = (const float*)(p.ws + WS_P); const float* mu = p.in[14];
    bf16x8 aw[4];
    { const int m = 32 * tg + r32; const float* pr = P + (size_t)m * RIN; const float* pp = prev_row(p, P, m);
#pragma unroll
      for (int ks = 0; ks < 4; ++ks) aw[ks] = prep_afrag<1>(pr, pp, mu, 1536 + 16 * ks + 8 * hi); }
    const bf16x8* LW2 = (const bf16x8*)(p.ws + WS_LW2); float* DEC = (float*)(p.ws + WS_DEC); const float* w0 = p.in[15];
#pragma unroll 1
    for (int nt = 8 * h4; nt < 8 * h4 + 8; ++nt) { const int c = 32 * nt + r32;
        f32x16 d;
#pragma unroll
        for (int r = 0; r < 16; ++r) d[r] = 0.f;
#pragma unroll
        for (int ks = 0; ks < 4; ++ks) d = MFMA32(aw[ks], LW2[(nt * 4 + ks) * 64 + lane], d);
        const float w0c = w0[c];
#pragma unroll
        for (int r = 0; r < 16; ++r) { const int mt = 32 * tg + crow(r, hi); const float y = -(w0c + d[r]);
            const float sp = y > 20.f ? y : log1pf(expf(y)); const float w = -sp - 0.5f;
            DEC[(size_t)mt * AW + c] = expf(-expf(w)); } }
}
__device__ __forceinline__ void prep_g_task(const KP& p, int tg, int hp, int lane) {
    const int r32 = lane & 31, hi = lane >> 5;
    const float* P = (const float*)(p.ws + WS_P); const float* mu = p.in[14];
    bf16x8 ag[8];
    { const int m = 32 * tg + r32; const float* pr = P + (size_t)m * RIN; const float* pp = prev_row(p, P, m);
#pragma unroll
      for (int ks = 0; ks < 8; ++ks) ag[ks] = prep_afrag<2>(pr, pp, mu, 1664 + 16 * ks + 8 * hi); }
    const bf16x8* LG2 = (const bf16x8*)(p.ws + WS_LG2); float* Go = (float*)(p.ws + WS_G);
#pragma unroll 1
    for (int nt = 4 * hp; nt < 4 * hp + 4; ++nt) { const int c = 32 * nt + r32;
        f32x16 d;
#pragma unroll
        for (int r = 0; r < 16; ++r) d[r] = 0.f;
#pragma unroll
        for (int ks = 0; ks < 8; ++ks) d = MFMA32(ag[ks], LG2[(nt * 8 + ks) * 64 + lane], d);
#pragma unroll
        for (int r = 0; r < 16; ++r) Go[(size_t)(32 * tg + crow(r, hi)) * AW + c] = d[r]; }
}
constexpr int NTG = MT / 32, NT_PREP = 10 * NTG;
__device__ __forceinline__ void rwkv_prep_task(const KP& p, int tk, int lane) {
    if (tk < 4 * NTG) prep_a_task(p, tk >> 2, tk & 3, lane);
    else if (tk < 6 * NTG) { const int t = tk - 4 * NTG; prep_w_task(p, t >> 1, t & 1, lane); }
    else { const int t = tk - 6 * NTG; prep_g_task(p, t >> 2, t & 3, lane); }
}

constexpr int TC = 32, SC_ARR = TC * 64 * 4, SC_BUF = 5 * SC_ARR + TC * 16 * 4 * 2;
__device__ __forceinline__ void scan_fill(const KP& p, LAS unsigned char* buf, int b, int h, int qr, int c, int lt) {
    const float* P = (const float*)(p.ws + WS_P); const float* mu = p.in[14]; const float* zrow = (const float*)(p.ws + WS_CTL + ZROW_OFF);
    const float* src[4] = {(const float*)(p.ws + WS_DEC), (const float*)(p.ws + WS_KP), (const float*)(p.ws + WS_KK), (const float*)(p.ws + WS_KKA)};
#pragma unroll
    for (int i = 0; i < 2; ++i) { const int idx = lt + 256 * i, t = idx >> 4, j4 = idx & 15; const size_t m = (size_t)b * SEQ + c * TC + t;
#pragma unroll
        for (int a = 0; a < 4; ++a) *(LAS f32x4*)(buf + a * SC_ARR + t * 256 + j4 * 16) = *(const f32x4*)(src[a] + m * AW + h * HD + 4 * j4);
        const float* pp = (c * TC + t) == 0 ? zrow : P + m * RIN - RIN;
        const f32x4 r0 = *(const f32x4*)(P + m * RIN + h * HD + 4 * j4), r1 = *(const f32x4*)(pp + h * HD + 4 * j4), mr = *(const f32x4*)(mu + h * HD + 4 * j4);
        *(LAS f32x4*)(buf + 4 * SC_ARR + t * 256 + j4 * 16) = r0 + (r1 - r0) * mr; }
    if (lt < 128) { const int t = lt >> 2, i4 = lt & 3; const size_t m = (size_t)b * SEQ + c * TC + t; const int cc = 1024 + h * HD + 16 * qr + 4 * i4;
        const float* pp = (c * TC + t) == 0 ? zrow : P + m * RIN - RIN;
        const f32x4 v0 = *(const f32x4*)(P + m * RIN + cc), v1 = *(const f32x4*)(pp + cc), mv = *(const f32x4*)(mu + cc);
        *(LAS f32x4*)(buf + 5 * SC_ARR + t * 64 + i4 * 16) = v0 + (v1 - v0) * mv; }
}
__device__ __forceinline__ void scan_prompt_item(const KP& p, int item, LAS unsigned char* lds, int tid) {
    const int b = item >> 5, h = (item >> 2) & 7, qr = item & 3;
    const int wave = __builtin_amdgcn_readfirstlane(tid >> 6), lane = tid & 63, lt = tid - 256;
    const bool scanner = wave < 4;
    const int il = lane >> 4, js = lane & 15, irow = 4 * (wave & 3) + il;
    f32x4 S = {0.f, 0.f, 0.f, 0.f};
    constexpr int NC = SEQ / TC;
    __syncthreads();
    if (!scanner) scan_fill(p, lds, b, h, qr, 0, lt);
    __syncthreads();
#pragma unroll 1
    for (int c = 0; c < NC; ++c) {
        LAS unsigned char* buf = lds + (c & 1) * SC_BUF;
        if (scanner) {
            LAS float* ob = (LAS float*)(buf + 5 * SC_ARR + TC * 64);
#pragma unroll 4
            for (int t = 0; t < TC; ++t) {
                const f32x4 w = *(const LAS f32x4*)(buf + t * 256 + js * 16), kp = *(const LAS f32x4*)(buf + SC_ARR + t * 256 + js * 16);
                const f32x4 kk = *(const LAS f32x4*)(buf + 2 * SC_ARR + t * 256 + js * 16), kka = *(const LAS f32x4*)(buf + 3 * SC_ARR + t * 256 + js * 16);
                const f32x4 rv = *(const LAS f32x4*)(buf + 4 * SC_ARR + t * 256 + js * 16);
                const float vv = *(const LAS float*)(buf + 5 * SC_ARR + t * 64 + irow * 4);
                float d = (S.x * kk.x + S.y * kk.y) + (S.z * kk.z + S.w * kk.w);
                d = sum16(d);
                const f32x4 T = S * w + kp * vv;
                S = T - kka * d;
                float o = (S.x * rv.x + S.y * rv.y) + (S.z * rv.z + S.w * rv.w);
                o = sum16(o);
                if (js == 0) ob[t * 16 + irow] = o;
            }
        } else {
            if (c + 1 < NC) scan_fill(p, lds + ((c + 1) & 1) * SC_BUF, b, h, qr, c + 1, lt);
        }
        __syncthreads();
        if (!scanner && lt < 128) { const int t = lt >> 2, i4 = lt & 3; const size_t m = (size_t)b * SEQ + c * TC + t;
            *(f32x4*)((float*)(p.ws + WS_SOUT) + m * AW + h * HD + 16 * qr + 4 * i4) = *(const LAS f32x4*)(buf + 5 * SC_ARR + TC * 64 + t * 64 + i4 * 16); }
    }
    if (scanner) *(f32x4*)(p.out + O_WKVP + ((size_t)(b * 8 + h) * 64 + 16 * qr + irow) * 64 + 4 * js) = S;
    __syncthreads();
}

__device__ __forceinline__ void scan_sample_task(const KP& p, int tk, int lane) {
    const int rg = tk & 3, h = (tk >> 2) & 7, db = tk >> 5;
    const int il = lane >> 2, js = lane & 3, i = 16 * rg + il;
    const float* P = (const float*)(p.ws + WS_P); const float* mu = p.in[14];
    const float* DEC = (const float*)(p.ws + WS_DEC); const float* KPi = (const float*)(p.ws + WS_KP); const float* KKi = (const float*)(p.ws + WS_KK); const float* KKAi = (const float*)(p.ws + WS_KKA);
    float* SO = (float*)(p.ws + WS_SOUT);
    const size_t sbase = (((size_t)db * 8 + h) * 64 + i) * 64 + 16 * js;
    f32x4 S[4];
#pragma unroll
    for (int q = 0; q < 4; ++q) S[q] = *(const f32x4*)(p.in[4] + sbase + 4 * q);
    const int cj = h * HD + 16 * js, cv = 1024 + h * HD + i;
    f32x4 mur[4];
#pragma unroll
    for (int q = 0; q < 4; ++q) mur[q] = *(const f32x4*)(mu + cj + 4 * q);
    const float muv = mu[cv];
#pragma unroll 1
    for (int t = 0; t < 8; ++t) {
        const size_t m = (size_t)NP + db * 8 + t;
        const float* pr = P + m * RIN; const float* pp = (t == 0) ? p.in[5] + (size_t)db * RIN : pr - RIN;
        float d = 0.f; f32x4 kk[4];
#pragma unroll
        for (int q = 0; q < 4; ++q) { kk[q] = *(const f32x4*)(KKi + m * AW + cj + 4 * q); d += (S[q].x * kk[q].x + S[q].y * kk[q].y) + (S[q].z * kk[q].z + S[q].w * kk[q].w); }
        d = sum4(d);
        const float v0 = pr[cv], v1 = pp[cv], vv = v0 + (v1 - v0) * muv;
        float o = 0.f;
#pragma unroll
        for (int q = 0; q < 4; ++q) { const f32x4 w = *(const f32x4*)(DEC + m * AW + cj + 4 * q), kp = *(const f32x4*)(KPi + m * AW + cj + 4 * q), kka = *(const f32x4*)(KKAi + m * AW + cj + 4 * q);
            const f32x4 r0 = *(const f32x4*)(pr + cj + 4 * q), r1 = *(const f32x4*)(pp + cj + 4 * q); const f32x4 rv = r0 + (r1 - r0) * mur[q];
            S[q] = S[q] * w + kp * vv - kka * d;
            o += (S[q].x * rv.x + S[q].y * rv.y) + (S[q].z * rv.z + S[q].w * rv.w); }
        o = sum4(o);
        if (js == 0) SO[m * AW + h * HD + i] = o;
    }
#pragma unroll
    for (int q = 0; q < 4; ++q) *(f32x4*)(p.out + O_WKVS + sbase + 4 * q) = S[q];
}

template <int NQ, int Q0> __device__ __forceinline__ void attn_sample_stream(const KP& p, int db, int br, int dil, int cls, int lane) {
    const int h = lane >> 3, c8 = lane & 7, co = h * HD + 8 * c8;
    const bf16* Q = (const bf16*)(p.ws + WS_Q);
    float q[NQ][8], mx[NQ], l[NQ], o[NQ][8];
#pragma unroll
    for (int qi = 0; qi < NQ; ++qi) { const size_t m = (size_t)NP + db * 8 + cls + dil * (Q0 + qi); const v4u w = *(const v4u*)(Q + m * AW + co);
        q[qi][0] = bf2f(w.x & 0xffff); q[qi][1] = bf2f(w.x >> 16); q[qi][2] = bf2f(w.y & 0xffff); q[qi][3] = bf2f(w.y >> 16);
        q[qi][4] = bf2f(w.z & 0xffff); q[qi][5] = bf2f(w.z >> 16); q[qi][6] = bf2f(w.w & 0xffff); q[qi][7] = bf2f(w.w >> 16);
        mx[qi] = -1e30f; l[qi] = 0.f;
#pragma unroll
        for (int e = 0; e < 8; ++e) o[qi][e] = 0.f; }
    const float* CK = p.in[2] + (size_t)db * WBUF * AW; const float* CV = p.in[3] + (size_t)db * WBUF * AW;
    const int row0 = WBUF - 128 * dil + cls;
#define SROW(POS, KA, KB, VA, VB) do { \
        _Pragma("unroll") for (int qi = 0; qi < NQ; ++qi) { \
            float s = (q[qi][0] * KA.x + q[qi][1] * KA.y) + (q[qi][2] * KA.z + q[qi][3] * KA.w) + (q[qi][4] * KB.x + q[qi][5] * KB.y) + (q[qi][6] * KB.z + q[qi][7] * KB.w); \
            s = sum8(s); const bool ok = ((POS) >= Q0 + qi) && ((POS) <= 128 + Q0 + qi); \
            const float mn = ok ? fmaxf(mx[qi], s) : mx[qi]; const float al = __builtin_amdgcn_exp2f(mx[qi] - mn); const float pe = ok ? __builtin_amdgcn_exp2f(s - mn) : 0.f; \
            mx[qi] = mn; l[qi] = l[qi] * al + pe; \
            o[qi][0] = o[qi][0] * al + pe * VA.x; o[qi][1] = o[qi][1] * al + pe * VA.y; o[qi][2] = o[qi][2] * al + pe * VA.z; o[qi][3] = o[qi][3] * al + pe * VA.w; \
            o[qi][4] = o[qi][4] * al + pe * VB.x; o[qi][5] = o[qi][5] * al + pe * VB.y; o[qi][6] = o[qi][6] * al + pe * VB.z; o[qi][7] = o[qi][7] * al + pe * VB.w; } } while (0)
#pragma unroll 1
    for (int pos = 0; pos < 128; pos += 4) {
        f32x4 ka[4], kb[4], va[4], vb_[4];
#pragma unroll
        for (int u = 0; u < 4; ++u) { const size_t ro = (size_t)(row0 + dil * (pos + u)) * AW + co;
            ka[u] = __builtin_nontemporal_load((const f32x4*)(CK + ro)); kb[u] = __builtin_nontemporal_load((const f32x4*)(CK + ro + 4));
            va[u] = __builtin_nontemporal_load((const f32x4*)(CV + ro)); vb_[u] = __builtin_nontemporal_load((const f32x4*)(CV + ro + 4)); }
#pragma unroll
        for (int u = 0; u < 4; ++u) SROW(pos + u, ka[u], kb[u], va[u], vb_[u]);
    }
#pragma unroll
    for (int n = 0; n < Q0 + NQ; ++n) { const size_t mo = ((size_t)db * 8 + cls + dil * n) * AW + co;
        const f32x4 ka = *(const f32x4*)(p.out + O_KS + mo), kb = *(const f32x4*)(p.out + O_KS + mo + 4), va = *(const f32x4*)(p.out + O_VS + mo), vb_ = *(const f32x4*)(p.out + O_VS + mo + 4);
        SROW(128 + n, ka, kb, va, vb_); }
#undef SROW
    bf16* AP = (bf16*)(p.ws + WS_APART) + (size_t)br * MT * AW; float* L = (float*)(p.ws + WS_LSE) + (size_t)br * MT * 8;
#pragma unroll
    for (int qi = 0; qi < NQ; ++qi) { const size_t m = (size_t)NP + db * 8 + cls + dil * (Q0 + qi); const float rl = 1.0f / l[qi];
        v4u w; w.x = cvt_pk_bf16(o[qi][0] * rl, o[qi][1] * rl); w.y = cvt_pk_bf16(o[qi][2] * rl, o[qi][3] * rl); w.z = cvt_pk_bf16(o[qi][4] * rl, o[qi][5] * rl); w.w = cvt_pk_bf16(o[qi][6] * rl, o[qi][7] * rl);
        *(v4u*)(AP + m * AW + co) = w;
        if (c8 == 0) L[m * 8 + h] = mx[qi] + __builtin_amdgcn_logf(l[qi]); }
}
__device__ __forceinline__ void attn_sample_task(const KP& p, int tk, int lane) {
    const int db = tk / 14, s = tk % 14;
    if (s == 0) attn_sample_stream<4, 0>(p, db, 0, 1, 0, lane);
    else if (s == 1) attn_sample_stream<4, 4>(p, db, 0, 1, 0, lane);
    else if (s < 6) attn_sample_stream<2, 0>(p, db, 1, 4, s - 2, lane);
    else attn_sample_stream<1, 0>(p, db, 2, 16, s - 6, lane);
}

__device__ __forceinline__ void combine_rows(const KP& p, int vcu, int G, int tid) {
    const int wave = __builtin_amdgcn_readfirstlane(tid >> 6), lane = tid & 63, gw = vcu * NWAVES + wave, NGW = G * NWAVES;
    const int h = lane >> 3, c8 = lane & 7, co = h * HD + 8 * c8;
    const bf16* AP = (const bf16*)(p.ws + WS_APART); const float* L = (const float*)(p.ws + WS_LSE);
    const float* P = (const float*)(p.ws + WS_P); const float* mu = p.in[14]; const float* SO = (const float*)(p.ws + WS_SOUT); const float* Gi = (const float*)(p.ws + WS_G); const float* BON = (const float*)(p.ws + WS_BON);
    const float* lg = p.in[23]; const float* lb = p.in[24];
    bf16* MIX = (bf16*)(p.ws + WS_MIX);
    const f32x4 g0 = *(const f32x4*)(lg + co), g1 = *(const f32x4*)(lg + co + 4), b0 = *(const f32x4*)(lb + co), b1 = *(const f32x4*)(lb + co + 4);
    const f32x4 mv0 = *(const f32x4*)(mu + 1024 + co), mv1 = *(const f32x4*)(mu + 1024 + co + 4);
    for (int m = gw; m < MT; m += NGW) {
        const float l0 = L[(size_t)m * 8 + h], l1 = L[((size_t)MT + m) * 8 + h], l2 = L[((size_t)2 * MT + m) * 8 + h];
        const float lm = fmaxf(l0, fmaxf(l1, l2));
        float w0 = __builtin_amdgcn_exp2f(l0 - lm), w1 = __builtin_amdgcn_exp2f(l1 - lm), w2 = __builtin_amdgcn_exp2f(l2 - lm); const float ws_ = 1.0f / (w0 + w1 + w2); w0 *= ws_; w1 *= ws_; w2 *= ws_;
        const v4u a0 = *(const v4u*)(AP + (size_t)m * AW + co), a1 = *(const v4u*)(AP + ((size_t)MT + m) * AW + co), a2 = *(const v4u*)(AP + ((size_t)2 * MT + m) * AW + co);
        float at[8];
#pragma unroll
        for (int e = 0; e < 4; ++e) { at[2 * e] = w0 * bf2f(a0[e] & 0xffff) + w1 * bf2f(a1[e] & 0xffff) + w2 * bf2f(a2[e] & 0xffff); at[2 * e + 1] = w0 * bf2f(a0[e] >> 16) + w1 * bf2f(a1[e] >> 16) + w2 * bf2f(a2[e] >> 16); }
        v4u wo; wo.x = cvt_pk_bf16(at[0], at[1]); wo.y = cvt_pk_bf16(at[2], at[3]); wo.z = cvt_pk_bf16(at[4], at[5]); wo.w = cvt_pk_bf16(at[6], at[7]);
        *(v4u*)(MIX + (size_t)m * DM + co) = wo;
        const f32x4 o0 = *(const f32x4*)(SO + (size_t)m * AW + co), o1 = *(const f32x4*)(SO + (size_t)m * AW + co + 4);
        const float mean = sum8((o0.x + o0.y) + (o0.z + o0.w) + (o1.x + o1.y) + (o1.z + o1.w)) * (1.0f / 64.0f);
        const f32x4 d0 = o0 - mean, d1 = o1 - mean;
        const float var = sum8((d0.x * d0.x + d0.y * d0.y) + (d0.z * d0.z + d0.w * d0.w) + (d1.x * d1.x + d1.y * d1.y) + (d1.z * d1.z + d1.w * d1.w)) * (1.0f / 64.0f);
        const float rs = 1.0f / sqrtf(var + LNX_EPS);
        const float* pr = P + (size_t)m * RIN + 1024 + co; const float* pp = pr - RIN;
        if (m < NP) { if ((m & 2047) == 0) pp = (const float*)(p.ws + WS_CTL + ZROW_OFF); } else { const int ms = m - NP; if ((ms & 7) == 0) pp = p.in[5] + (size_t)(ms >> 3) * RIN + 1024 + co; }
        const f32x4 va = *(const f32x4*)pr, vb_ = *(const f32x4*)(pr + 4), qa = *(const f32x4*)pp, qb = *(const f32x4*)(pp + 4);
        const f32x4 v0 = va + (qa - va) * mv0, v1 = vb_ + (qb - vb_) * mv1;
        const float bon = BON[(size_t)m * 8 + h];
        const f32x4 gg0 = *(const f32x4*)(Gi + (size_t)m * AW + co), gg1 = *(const f32x4*)(Gi + (size_t)m * AW + co + 4);
        const f32x4 y0 = (d0 * rs * g0 + b0 + v0 * bon) * gg0, y1 = (d1 * rs * g1 + b1 + v1 * bon) * gg1;
        v4u wr_; wr_.x = cvt_pk_bf16(y0.x, y0.y); wr_.y = cvt_pk_bf16(y0.z, y0.w); wr_.z = cvt_pk_bf16(y1.x, y1.y); wr_.w = cvt_pk_bf16(y1.z, y1.w);
        *(v4u*)(MIX + (size_t)m * DM + AW + co) = wr_;
    }
}

#ifndef PHM
#define PHM 0xFFF
#endif
#define PH(k) if constexpr (((PHM) >> (k)) & 1)
__global__ void __launch_bounds__(NWAVES * 64, 2) hybrid_fwd(KP p) {
    extern __shared__ __attribute__((aligned(16))) unsigned char lds_raw[];
    LAS unsigned char* lds = (LAS unsigned char*)lds_raw;
    volatile LAS unsigned* MISC = (volatile LAS unsigned*)(lds + MISC_OFF);
    const int tid = threadIdx.x, lane = tid & 63, wave = __builtin_amdgcn_readfirstlane(tid >> 6);
    const int G = gridDim.x; int vcu; { const int bx = blockIdx.x; vcu = (G % 8 == 0) ? (bx % 8) * (G / 8) + bx / 8 : bx; }
    for (int u = tid; u < (LDS_BYTES - LDSCTL_OFF) / 4; u += NWAVES * 64) ((LAS unsigned*)(lds + LDSCTL_OFF))[u] = 0u;
    __syncthreads();
    XcdBarrier bar = xcd_barrier_post((unsigned*)(p.ws + WS_CTL) + CW_BAR, MISC + 8);
    const int gw = vcu * NWAVES + wave, NGW = G * NWAVES;
    float* mod = (float*)(p.ws + WS_MOD);

    PH(0) p0_prologue(p, lds, vcu, G, tid);
    xcd_barrier(bar);
    PH(1) { pg8::Gemm g{(const pg8::bf16_t*)(p.ws + WS_SILU), (const pg8::bf16_t*)(p.ws + WS_WADA), 256, MODW, DM}; pg8::StaticOrder S; S.init(256, MODW, G, (int)blockIdx.x);
      pg8::EpiAda E{mod, MODW, p.in[11]};
      pg8::gemm_phase<pg8::EpiAda, pg8::StaticOrder, false, true>(lds + RING_OFF, g, S, E); }
    xcd_barrier(bar);
    PH(2) norm_mod_rows(p.in[0], p.in[1], p.in[8], mod, 0, 1024, (bf16*)(p.ws + WS_H), vcu, G, tid);
    xcd_barrier(bar);
    PH(3) { pg8::Gemm g{(const pg8::bf16_t*)(p.ws + WS_H), (const pg8::bf16_t*)(p.ws + WS_WIN), MT, INW, DM}; pg8::StaticOrder S; S.init(MT, INW, G, (int)blockIdx.x);
      static_assert(WS_K - WS_Q == WS_V - WS_K, "q/k/v buffers equally spaced");
      pg8::EpiProj E{(pg8::bf16_t*)(p.ws + WS_Q), (WS_K - WS_Q) / 2, (float*)(p.ws + WS_P), (const float*)(p.ws + WS_ROPE),
                     p.out, O_KP, O_VP - O_KP, O_KS, O_VS - O_KS, p.out + O_SHP, p.out + O_SHS, QC2};
      pg8::gemm_phase<pg8::EpiProj, pg8::StaticOrder, true, true>(lds + RING_OFF, g, S, E); }
    xcd_barrier(bar);
    PH(4) { LAS unsigned char* wl = lds + RING_OFF + wave * 5120;
      constexpr int NTA = 64 * 192, NTP = NT_PREP;
#ifndef NO_ATT
#pragma unroll 1
      for (int tk = gw; tk < NTA; tk += NGW) attn_prompt_task(p, tk, wl, lane);
#endif
#ifndef NO_PREP
#pragma unroll 1
      for (int tk = (gw + NGW - (NTA % NGW)) % NGW; tk < 4 * NTG; tk += NGW) prep_a_task(p, tk >> 2, tk & 3, lane);
#pragma unroll 1
      for (int tk = gw; tk < 2 * NTG; tk += NGW) prep_w_task(p, tk >> 1, tk & 1, lane);
#pragma unroll 1
      for (int tk = NGW - 1 - gw; tk < 4 * NTG; tk += NGW) prep_g_task(p, tk >> 2, tk & 3, lane);
#endif
    }
    xcd_barrier(bar);
#ifndef NO_PSCAN
    PH(5) for (int item = blockIdx.x; item < 256; item += G) scan_prompt_item(p, item, lds + RING_OFF, tid);
#endif
    PH(5) { constexpr int NTS = NDB * 14, NTC = NDB * 32;
      for (int tk = gw; tk < NTS + NTC; tk += NGW) {
#ifndef NO_SATT
          if (tk < NTS) attn_sample_task(p, tk, lane);
#endif
#ifndef NO_SSCAN
          if (tk >= NTS) scan_sample_task(p, tk - NTS, lane);
#endif
      } }
    xcd_barrier(bar);
    PH(6) combine_rows(p, vcu, G, tid);
    xcd_barrier(bar);
    PH(7) { pg8::Gemm g{(const pg8::bf16_t*)(p.ws + WS_MIX), (const pg8::bf16_t*)(p.ws + WS_WOUT), MT, DM, DM}; pg8::StaticOrder S; S.init(MT, DM, G, (int)blockIdx.x);
      pg8::EpiRes E{p.in[0], p.in[1], NP, (float*)(p.ws + WS_X1), DM, mod + 2048, MODW};
      pg8::gemm_phase<pg8::EpiRes, pg8::StaticOrder, true, true>(lds + RING_OFF, g, S, E); }
    xcd_barrier(bar);
    PH(8) norm_mod_rows((const float*)(p.ws + WS_X1), (const float*)(p.ws + WS_X1) + (size_t)NP * DM, p.in[9], mod, 3072, 4096, (bf16*)(p.ws + WS_H), vcu, G, tid);
    xcd_barrier(bar);
    PH(9) { pg8::Gemm g{(const pg8::bf16_t*)(p.ws + WS_H), (const pg8::bf16_t*)(p.ws + WS_WFF1), MT, DFF, DM}; pg8::StaticOrder S; S.init(MT, DFF, G, (int)blockIdx.x);
      pg8::EpiRelu2 E{(pg8::bf16_t*)(p.ws + WS_U), DFF};
      pg8::gemm_phase<pg8::EpiRelu2, pg8::StaticOrder, true, true>(lds + RING_OFF, g, S, E); }
    xcd_barrier(bar);
    PH(10) { pg8::Gemm g{(const pg8::bf16_t*)(p.ws + WS_U), (const pg8::bf16_t*)(p.ws + WS_WFF2), MT, DM, DFF}; pg8::StaticOrder S; S.init(MT, DM, G, (int)blockIdx.x);
      pg8::EpiRes E{(const float*)(p.ws + WS_X1), (const float*)(p.ws + WS_X1) + (size_t)NP * DM, NP, (float*)(p.ws + WS_X2), DM, mod + 5120, MODW};
      pg8::gemm_phase<pg8::EpiRes, pg8::StaticOrder, true, true>(lds + RING_OFF, g, S, E); }
    xcd_barrier(bar);
    PH(11) final_norm_rows((const float*)(p.ws + WS_X2), p.in[27], p.out + O_YP, vcu, G, tid);
}

extern "C" void kernel_launch(void* const* d_in, const int* in_sizes, int n_in, void* d_out, int out_size, void* d_ws, size_t ws_size, hipStream_t stream) {
    static int grid = 0;
    if (grid == 0) {
        if (n_in != 28 || (size_t)out_size != O_END || ws_size < WS_END) { fprintf(stderr, "kernel_launch: unexpected shapes (n_in %d out %d ws %zu)\n", n_in, out_size, ws_size); grid = -1; return; }
        int dev = 0, cus = 0, per_cu = 0;
        if (hipGetDevice(&dev) != hipSuccess || hipDeviceGetAttribute(&cus, hipDeviceAttributeMultiprocessorCount, dev) != hipSuccess) { grid = -1; return; }
        if (hipFuncSetAttribute((const void*)hybrid_fwd, hipFuncAttributeMaxDynamicSharedMemorySize, LDS_BYTES) != hipSuccess) { fprintf(stderr, "kernel_launch: hipFuncSetAttribute failed\n"); grid = -1; return; }
        if (hipOccupancyMaxActiveBlocksPerMultiprocessor(&per_cu, (const void*)hybrid_fwd, NWAVES * 64, LDS_BYTES) != hipSuccess || per_cu < 1) fprintf(stderr, "kernel_launch: occupancy query reports %d\n", per_cu);
        (void)hipGetLastError();
        grid = cus;
    }
    if (grid < 0) return;
    if (hipMemsetAsync((char*)d_ws + WS_CTL, 0, CTL_ZERO_BYTES, stream) != hipSuccess) return;
    KP a{};
    for (int i = 0; i < 28; ++i) a.in[i] = (const float*)d_in[i];
    a.out = (float*)d_out; a.ws = (unsigned char*)d_ws;
    hipLaunchKernelGGL(hybrid_fwd, dim3(grid), dim3(NWAVES * 64), LDS_BYTES, stream, a);
}
```

```cpp
#include <hip/hip_runtime.h>
#include <cstdio>
#include <cstdint>
#include <cmath>
namespace pg8 {
#define PG8_LAS __attribute__((address_space(3)))
typedef unsigned short bf16_t;
typedef short bf16x8 __attribute__((ext_vector_type(8)));
typedef float f32x4 __attribute__((ext_vector_type(4)));
typedef unsigned u32x4 __attribute__((ext_vector_type(4)));
constexpr int BM = 256, BK = 64, HALF = 128, HTB = HALF * BK * 2  , STAGE_BYTES = 8 * HTB, NXCD = 8, WGM = 8;

__host__ __device__ __forceinline__ int lds_byte(int r, int c) { const int st = (r >> 4) * 2 + (c >> 5), rr = r & 15, cc = c & 31, ob = rr * 64 + cc * 2; return st * 1024 + (ob ^ (((ob >> 9) & 1) << 5)); }
__host__ __device__ __forceinline__ void stage_rc(int b, int& R, int& C) { const int st = b / 1024, sb = b % 1024, swz = sb ^ (((sb >> 9) & 1) << 5); R = (st >> 1) * 16 + swz / 64; C = (st & 1) * 32 + (swz % 64) / 2; }
__host__ __device__ __forceinline__ int perm32(int rho) { const int n = rho >> 4, i = rho & 15; return 8 * (i >> 2) + 4 * n + (i & 3); }

struct Unit { int pm, pn; };
struct Gemm { const bf16_t* A; const bf16_t* Bt; int M, N, K; };

struct StaticOrder {
    int nM, nN, nwg, G, c;
    __host__ __device__ void init(int M, int N, int G_, int c_) { nM = M / BM; nN = N / BM; nwg = nM * nN; G = G_; c = c_; }
    __host__ __device__ bool next(int i, Unit& u) const {
        const long L = (long)i * G + c; if (L >= nwg) return false;
        int wgid = (int)L; { const int q = nwg / NXCD, r = nwg % NXCD, xcd = wgid % NXCD, off = wgid / NXCD; wgid = (xcd < r ? xcd * (q + 1) : r * (q + 1) + (xcd - r) * q) + off; }
        const int nig = WGM * nN, gid = wgid / nig, fm = gid * WGM, gsz = (nM - fm) < WGM ? (nM - fm) : WGM;
        u.pm = fm + ((wgid % nig) % gsz); u.pn = (wgid % nig) / gsz; return true;
    }
    __device__ __forceinline__ void a_ready(const Unit&) const {}
    __device__ __forceinline__ void done(const Unit&) const {}
};

typedef float f32x2 __attribute__((ext_vector_type(2)));
typedef __bf16 bf16x2_t __attribute__((ext_vector_type(2)));
__device__ __forceinline__ unsigned cvt_pk_bf16(float lo, float hi) { f32x2 v = {lo, hi}; bf16x2_t b = __builtin_convertvector(v, bf16x2_t); return __builtin_bit_cast(unsigned, b); }

constexpr int E_NP = 16384;
__device__ __forceinline__ int e_modrow(int m) { return m < E_NP ? (m >> 11) : 8 + ((m - E_NP) >> 3); }

struct EpiAda {
    static constexpr bool PERM = false, AFTER_DRAIN = false;
    float* out; int ldc; const float* bias;
    __device__ __forceinline__ void operator()(const f32x4 (&acc)[2][2][4][2], const Unit& u, int wr, int wc, int fr, int fq) const {
        const int row0 = u.pm * BM + wr * 64 + fr, col0 = u.pn * BM + wc * 32 + 4 * fq;
#pragma unroll
        for (int ai = 0; ai < 2; ++ai)
#pragma unroll
            for (int m = 0; m < 4; ++m) { float* rowp = out + (size_t)(row0 + ai * HALF + m * 16) * ldc + col0;
#pragma unroll
                for (int bj = 0; bj < 2; ++bj)
#pragma unroll
                    for (int n = 0; n < 2; ++n) { const f32x4 bv = *(const f32x4*)(bias + col0 + bj * HALF + n * 16); *(f32x4*)(rowp + bj * HALF + n * 16) = acc[ai][bj][m][n] + bv; } }
    }
};
struct EpiRes {
    static constexpr bool PERM = false, AFTER_DRAIN = false;
    const float* base0; const float* base1; int split; float* out; int ldc; const float* gate; int gate_ld;
    __device__ __forceinline__ void operator()(const f32x4 (&acc)[2][2][4][2], const Unit& u, int wr, int wc, int fr, int fq) const {
        const int row0 = u.pm * BM + wr * 64 + fr, col0 = u.pn * BM + wc * 32 + 4 * fq;
#pragma unroll
        for (int ai = 0; ai < 2; ++ai)
#pragma unroll
            for (int m = 0; m < 4; ++m) { const int row = row0 + ai * HALF + m * 16;
                const float* bp = (row < split ? base0 + (size_t)row * ldc : base1 + (size_t)(row - split) * ldc) + col0;
                const float* gp = gate + (size_t)e_modrow(row) * gate_ld + col0; float* rowp = out + (size_t)row * ldc + col0;
#pragma unroll
                for (int bj = 0; bj < 2; ++bj)
#pragma unroll
                    for (int n = 0; n < 2; ++n) { const int o = bj * HALF + n * 16; const f32x4 bs = *(const f32x4*)(bp + o), g = *(const f32x4*)(gp + o); *(f32x4*)(rowp + o) = bs + g * acc[ai][bj][m][n]; } }
    }
};
struct EpiRelu2 {
    static constexpr bool PERM = true, AFTER_DRAIN = false;
    bf16_t* O; int ldc;
    __device__ __forceinline__ void operator()(const f32x4 (&acc)[2][2][4][2], const Unit& u, int wr, int wc, int fr, int fq) const {
        const int row0 = u.pm * BM + wr * 64 + fr, col0 = u.pn * BM + wc * 32 + 8 * fq;
#pragma unroll
        for (int ai = 0; ai < 2; ++ai)
#pragma unroll
            for (int m = 0; m < 4; ++m) { bf16_t* rowp = O + (size_t)(row0 + ai * HALF + m * 16) * ldc + col0;
#pragma unroll
                for (int bj = 0; bj < 2; ++bj) { f32x4 v0 = acc[ai][bj][m][0], v1 = acc[ai][bj][m][1];
                    v0 = __builtin_elementwise_max(v0, (f32x4){0.f, 0.f, 0.f, 0.f}); v1 = __builtin_elementwise_max(v1, (f32x4){0.f, 0.f, 0.f, 0.f}); v0 = v0 * v0; v1 = v1 * v1;
                    u32x4 w; w.x = cvt_pk_bf16(v0[0], v0[1]); w.y = cvt_pk_bf16(v0[2], v0[3]); w.z = cvt_pk_bf16(v1[0], v1[1]); w.w = cvt_pk_bf16(v1[2], v1[3]);
                    *(u32x4*)(rowp + bj * HALF) = w; } }
    }
};
struct EpiProj {
    static constexpr bool PERM = true, AFTER_DRAIN = false;
    bf16_t* QKV; size_t qkv_stride; float* P; const float* rope;
    float* outp; size_t o_kp, o_kv_step_p, o_ks, o_kv_step_s; float *shift_p, *shift_s; float c2;
    __device__ __forceinline__ void operator()(const f32x4 (&acc)[2][2][4][2], const Unit& u, int wr, int wc, int fr, int fq) const {
        const int row0 = u.pm * BM + wr * 64 + fr, pn = u.pn;
        const int lcol = wc * 32 + 8 * fq;
        if (pn < 6) {
            const int kind = pn >> 1;
            const int c0 = (pn & 1) * 256 + lcol;
            const bool dorope = (kind < 2) && ((wc & 1) == 0);
#pragma unroll
            for (int ai = 0; ai < 2; ++ai)
#pragma unroll
                for (int m = 0; m < 4; ++m) { const int row = row0 + ai * HALF + m * 16;
                    f32x4 cs0 = {1.f, 1.f, 1.f, 1.f}, cs1 = cs0, sn0 = {0.f, 0.f, 0.f, 0.f}, sn1 = sn0;
                    if (dorope) { const int ridx = row < E_NP ? (row & 2047) : 2048 + ((row - E_NP) & 7); const float* rp = rope + (size_t)ridx * 16;
                        cs0 = *(const f32x4*)(rp); cs1 = *(const f32x4*)(rp + 4); sn0 = *(const f32x4*)(rp + 8); sn1 = *(const f32x4*)(rp + 12); }
#pragma unroll
                    for (int bj = 0; bj < 2; ++bj) { f32x4 v0 = acc[ai][bj][m][0], v1 = acc[ai][bj][m][1];
                        if (dorope) {
                            f32x4 p0, p1;
#pragma unroll
                            for (int e = 0; e < 4; ++e) { p0[e] = __shfl_xor(v0[e], 16); p1[e] = __shfl_xor(v1[e], 16); }
                            if (fq == 0) { v0 = v0 * cs0 - p0 * sn0; v1 = v1 * cs1 - p1 * sn1; }
                            else if (fq == 1) { v0 = p0 * sn0 + v0 * cs0; v1 = p1 * sn1 + v1 * cs1; }
                        }
                        const int c = c0 + bj * HALF;
                        if (kind >= 1) { float* fo = outp + (row < E_NP ? o_kp + (size_t)(kind - 1) * o_kv_step_p + (size_t)row * 512 : o_ks + (size_t)(kind - 1) * o_kv_step_s + (size_t)(row - E_NP) * 512);
                            *(f32x4*)(fo + c) = v0; *(f32x4*)(fo + c + 4) = v1; }
                        if (kind == 0) { v0 = v0 * c2; v1 = v1 * c2; }
                        u32x4 w; w.x = cvt_pk_bf16(v0[0], v0[1]); w.y = cvt_pk_bf16(v0[2], v0[3]); w.z = cvt_pk_bf16(v1[0], v1[1]); w.w = cvt_pk_bf16(v1[2], v1[3]);
                        bf16_t* bo = QKV + (size_t)kind * qkv_stride + (size_t)row * 512 + c;
                        *(u32x4*)bo = w; } }
        } else {
            const int c0 = (pn - 6) * 256 + lcol;
#pragma unroll
            for (int ai = 0; ai < 2; ++ai)
#pragma unroll
                for (int m = 0; m < 4; ++m) { const int row = row0 + ai * HALF + m * 16; float* po = P + (size_t)row * 1792 + c0;
                    float* so = nullptr;
                    if (row < E_NP) { if ((row & 2047) == 2047) so = shift_p + (size_t)(row >> 11) * 1792 + c0; }
                    else { const int ms = row - E_NP; if ((ms & 7) == 7) so = shift_s + (size_t)(ms >> 3) * 1792 + c0; }
#pragma unroll
                    for (int bj = 0; bj < 2; ++bj) { const f32x4 v0 = acc[ai][bj][m][0], v1 = acc[ai][bj][m][1];
                        *(f32x4*)(po + bj * HALF) = v0; *(f32x4*)(po + bj * HALF + 4) = v1;
                        if (so) { *(f32x4*)(so + bj * HALF) = v0; *(f32x4*)(so + bj * HALF + 4) = v1; } } }
        }
    }
};

template <class Epi, class Sched, bool ALIGN_EPI = false, bool SP2 = false>
__device__ __forceinline__ void gemm_phase(PG8_LAS unsigned char* lds, const Gemm g, const Sched& S, const Epi& E) {
    int tid_ = threadIdx.x; asm volatile("" : "+v"(tid_));
    const int tid = tid_, wid = __builtin_amdgcn_readfirstlane(tid >> 6), lane = tid & 63, wr = wid >> 2, wc = wid & 3, fr = lane & 15, fq = lane >> 4;
    const int K = g.K, nt = K / BK;
    unsigned voffA[2], voffB[2];
#pragma unroll
    for (int i = 0; i < 2; ++i) { int R, C; stage_rc(tid * 16 + i * 8192, R, C); const int Rb = Epi::PERM ? ((R & ~31) + perm32(R & 31)) : R;
        voffA[i] = (unsigned)(R * K + C) * 2u; voffB[i] = (unsigned)(Rb * K + C) * 2u; }
    const size_t kstep = (size_t)(BK * 2);
    const size_t hstep = (size_t)HALF * K * 2;
    const size_t tstep = 2 * hstep;
    const unsigned ldsw = (unsigned)wid * 1024u;
    const int aoff = lds_byte(wr * 64 + fr, fq * 8), boff = lds_byte(wc * 32 + fr, fq * 8);
#define PG8_SA(b, h) (((b) * 2 + (h)) * HTB)
#define PG8_SB(b, h) ((4 + (b) * 2 + (h)) * HTB)
#define PG8_STAGE(bufoff, gbase, voff) do { _Pragma("unroll") for (int _i = 0; _i < 2; ++_i) \
        __builtin_amdgcn_global_load_lds((const unsigned*)((const char*)(gbase) + (voff)[_i]), (PG8_LAS unsigned*)(lds + (bufoff) + ldsw + _i * 8192), 16, 0, 0); } while (0)
#define PG8_LDA(dst, b, h) do { _Pragma("unroll") for (int m = 0; m < 4; ++m) _Pragma("unroll") for (int k = 0; k < 2; ++k) dst[m][k] = *(const PG8_LAS bf16x8*)(lds + PG8_SA(b, h) + aoff + m * 2048 + k * 1024); } while (0)
#define PG8_LDB(dst, b, h) do { _Pragma("unroll") for (int n = 0; n < 2; ++n) _Pragma("unroll") for (int k = 0; k < 2; ++k) dst[n][k] = *(const PG8_LAS bf16x8*)(lds + PG8_SB(b, h) + boff + n * 2048 + k * 1024); } while (0)
#define PG8_MMA(ai, bj, At, Bt) do { __builtin_amdgcn_s_setprio(1); _Pragma("unroll") for (int m = 0; m < 4; ++m) _Pragma("unroll") for (int n = 0; n < 2; ++n) _Pragma("unroll") for (int k = 0; k < 2; ++k) \
        acc[ai][bj][m][n] = __builtin_amdgcn_mfma_f32_16x16x32_bf16(Bt[n][k], At[m][k], acc[ai][bj][m][n], 0, 0, 0); __builtin_amdgcn_s_setprio(0); } while (0)
#define PG8_WAIT_V(n) asm volatile("s_waitcnt vmcnt(" #n ")" ::: "memory")
#define PG8_WAIT_L(n) asm volatile("s_waitcnt lgkmcnt(" #n ")" ::: "memory")
#define PG8_BAR __builtin_amdgcn_s_barrier()
#define PG8_SCHED __builtin_amdgcn_sched_barrier(0)
    Unit cur, nxt; int ui = 0;
    if (!S.next(0, cur)) return;
    f32x4 acc[2][2][4][2];
#pragma unroll
    for (int a = 0; a < 2; ++a)
#pragma unroll
        for (int b = 0; b < 2; ++b)
#pragma unroll
            for (int m = 0; m < 4; ++m)
#pragma unroll
                for (int n = 0; n < 2; ++n) acc[a][b][m][n] = (f32x4){0.f, 0.f, 0.f, 0.f};
    bf16x8 At[4][2], B0[2][2], B1[2][2];
    const char* cA = (const char*)g.A + (size_t)cur.pm * tstep; const char* cB = (const char*)g.Bt + (size_t)cur.pn * tstep;
    S.a_ready(cur);
    if constexpr (SP2) {
        PG8_STAGE(PG8_SB(0, 0), cB, voffB); PG8_STAGE(PG8_SB(0, 1), cB + hstep, voffB); PG8_STAGE(PG8_SA(0, 0), cA, voffA); PG8_STAGE(PG8_SA(0, 1), cA + hstep, voffA);
        if (wr == 1) PG8_BAR;
        PG8_WAIT_V(2); PG8_BAR;
        PG8_STAGE(PG8_SB(1, 0), cB + kstep, voffB); PG8_STAGE(PG8_SA(1, 0), cA + kstep, voffA); PG8_STAGE(PG8_SB(1, 1), cB + hstep + kstep, voffB);
        PG8_WAIT_V(6); PG8_BAR;
    } else {
        PG8_STAGE(PG8_SB(0, 0), cB, voffB); PG8_STAGE(PG8_SA(0, 0), cA, voffA); PG8_STAGE(PG8_SB(0, 1), cB + hstep, voffB); PG8_STAGE(PG8_SA(0, 1), cA + hstep, voffA);
        if (wr == 1) PG8_BAR;
        PG8_WAIT_V(4); PG8_BAR;
        PG8_STAGE(PG8_SB(1, 0), cB + kstep, voffB); PG8_STAGE(PG8_SA(1, 0), cA + kstep, voffA); PG8_STAGE(PG8_SB(1, 1), cB + hstep + kstep, voffB);
        PG8_WAIT_V(6); PG8_BAR;
    }
    for (;;) {
        const bool has_next = S.next(ui + 1, nxt);
        const char* nA = has_next ? (const char*)g.A + (size_t)nxt.pm * tstep : cA; const char* nB = has_next ? (const char*)g.Bt + (size_t)nxt.pn * tstep : cB;
        for (int t = 0; t < nt; t += 2) {
            const bool last = (t == nt - 2);
            const char* a1 = cA + (size_t)(t + 1) * kstep;
            const char* a2 = last ? nA : cA + (size_t)(t + 2) * kstep; const char* b2 = last ? nB : cB + (size_t)(t + 2) * kstep;
            const char* a3 = a2 + kstep; const char* b3 = b2 + kstep;
            if (last && has_next) S.a_ready(nxt);
            if constexpr (SP2) {
            PG8_LDB(B0, 0, 0); PG8_LDB(B1, 0, 1); PG8_SCHED; PG8_LDA(At, 0, 0); PG8_STAGE(PG8_SA(1, 1), a1 + hstep, voffA);
            PG8_WAIT_V(8); PG8_WAIT_L(0); PG8_BAR; PG8_MMA(0, 0, At, B0); PG8_MMA(0, 1, At, B1); PG8_BAR; PG8_SCHED;
            PG8_LDA(At, 0, 1); PG8_STAGE(PG8_SB(0, 0), b2, voffB); PG8_STAGE(PG8_SB(0, 1), b2 + hstep, voffB); PG8_STAGE(PG8_SA(0, 0), a2, voffA);
            PG8_WAIT_V(8); PG8_WAIT_L(0); PG8_BAR; PG8_MMA(1, 0, At, B0); PG8_MMA(1, 1, At, B1); PG8_BAR; PG8_SCHED;
            PG8_LDB(B0, 1, 0); PG8_LDB(B1, 1, 1); PG8_SCHED; PG8_LDA(At, 1, 0); PG8_STAGE(PG8_SA(0, 1), a2 + hstep, voffA);
            PG8_WAIT_V(8); PG8_WAIT_L(0); PG8_BAR; PG8_MMA(0, 0, At, B0); PG8_MMA(0, 1, At, B1); PG8_BAR; PG8_SCHED;
            PG8_LDA(At, 1, 1); PG8_STAGE(PG8_SB(1, 0), b3, voffB); PG8_STAGE(PG8_SB(1, 1), b3 + hstep, voffB); PG8_STAGE(PG8_SA(1, 0), a3, voffA);
            PG8_WAIT_V(8); PG8_WAIT_L(0); PG8_BAR; PG8_MMA(1, 0, At, B0); PG8_MMA(1, 1, At, B1); PG8_BAR; PG8_SCHED;
            } else {
            PG8_LDB(B0, 0, 0); PG8_SCHED; PG8_LDA(At, 0, 0); PG8_STAGE(PG8_SA(1, 1), a1 + hstep, voffA);
            PG8_WAIT_L(8); PG8_BAR; PG8_WAIT_L(0); PG8_MMA(0, 0, At, B0); PG8_BAR; PG8_SCHED;
            PG8_LDB(B1, 0, 1); PG8_STAGE(PG8_SB(0, 0), b2, voffB);
            PG8_BAR; PG8_WAIT_L(0); PG8_MMA(0, 1, At, B1); PG8_BAR;
            PG8_LDA(At, 0, 1); PG8_STAGE(PG8_SA(0, 0), a2, voffA);
            PG8_BAR; PG8_WAIT_L(0); PG8_MMA(1, 0, At, B0); PG8_BAR; PG8_SCHED;
            PG8_STAGE(PG8_SB(0, 1), b2 + hstep, voffB);
            PG8_WAIT_V(6); PG8_BAR; PG8_MMA(1, 1, At, B1); PG8_BAR;
            PG8_LDB(B0, 1, 0); PG8_SCHED; PG8_LDA(At, 1, 0); PG8_STAGE(PG8_SA(0, 1), a2 + hstep, voffA);
            PG8_WAIT_L(8); PG8_BAR; PG8_WAIT_L(0); PG8_MMA(0, 0, At, B0); PG8_BAR; PG8_SCHED;
            PG8_LDB(B1, 1, 1); PG8_STAGE(PG8_SB(1, 0), b3, voffB);
            PG8_BAR; PG8_WAIT_L(0); PG8_MMA(0, 1, At, B1); PG8_BAR;
            PG8_LDA(At, 1, 1); PG8_STAGE(PG8_SA(1, 0), a3, voffA);
            PG8_BAR; PG8_WAIT_L(0); PG8_MMA(1, 0, At, B0); PG8_BAR; PG8_SCHED;
            PG8_STAGE(PG8_SB(1, 1), b3 + hstep, voffB);
            PG8_WAIT_V(6); PG8_BAR; PG8_MMA(1, 1, At, B1); PG8_BAR;
            }
        }
        if constexpr (ALIGN_EPI) { if (wr == 0) PG8_BAR; }
        if constexpr (!Epi::AFTER_DRAIN) { E(acc, cur, wr, wc, fr, fq); S.done(cur); }
        if (!has_next) break;
#pragma unroll
        for (int a = 0; a < 2; ++a)
#pragma unroll
            for (int b = 0; b < 2; ++b)
#pragma unroll
                for (int m = 0; m < 4; ++m)
#pragma unroll
                    for (int n = 0; n < 2; ++n) acc[a][b][m][n] = (f32x4){0.f, 0.f, 0.f, 0.f};
        cur = nxt; cA = nA; cB = nB; ++ui;
        if constexpr (ALIGN_EPI) { if (wr == 1) PG8_BAR; }
    }
    PG8_WAIT_V(0);
    if constexpr (!ALIGN_EPI) { if (wr == 0) PG8_BAR; }
    PG8_BAR;
    if constexpr (Epi::AFTER_DRAIN) { E.fused(acc, cur, wr, wc, fr, fq, lds, wid, lane); S.done(cur); }
#undef PG8_SA
#undef PG8_SB
#undef PG8_STAGE
#undef PG8_LDA
#undef PG8_LDB
#undef PG8_MMA
#undef PG8_WAIT_V
#undef PG8_WAIT_L
#undef PG8_BAR
#undef PG8_SCHED
}
}

#define GAS __attribute__((address_space(1)))
#define LAS __attribute__((address_space(3)))
typedef unsigned short bf16;
typedef unsigned v4u __attribute__((ext_vector_type(4)));
typedef float f32x4 __attribute__((ext_vector_type(4)));
typedef short bf16x8 __attribute__((ext_vector_type(8)));
typedef GAS unsigned gu32;
typedef GAS unsigned long long gu64;
#define RLX_AGENT __ATOMIC_RELAXED, __HIP_MEMORY_SCOPE_AGENT
#define LDS_WAIT() asm volatile("s_waitcnt lgkmcnt(0)" ::: "memory")
#define VM_WAIT() asm volatile("s_waitcnt vmcnt(0)" ::: "memory")
__device__ __forceinline__ unsigned long long rt() { return __builtin_amdgcn_s_memrealtime(); }
__device__ __forceinline__ unsigned f2bf(float f) { unsigned u = __builtin_bit_cast(unsigned, f); return (u + 0x7fffu + ((u >> 16) & 1u)) >> 16; }
__device__ __forceinline__ unsigned pk2(float lo, float hi) { return f2bf(lo) | (f2bf(hi) << 16); }
#define XB_TMO      128
#define XB_XCNT(j)  (256  + 64 * (j))
#define XB_XSUB(j)  (1280 + 64 * (j))
#define XB_XGEN(j)  (2304 + 64 * (j))
#define XB_TOP      3328
#define XB_TOPGEN   3392
#define XCD_BAR_WORDS 3456
#define XB_SPIN_CAP (1u << 18)

__device__ __forceinline__ unsigned xb_ld(unsigned* p)              { return __hip_atomic_load(p, __ATOMIC_RELAXED, __HIP_MEMORY_SCOPE_AGENT); }
__device__ __forceinline__ unsigned xb_add(unsigned* p, unsigned v) { return __hip_atomic_fetch_add(p, v, __ATOMIC_RELAXED, __HIP_MEMORY_SCOPE_AGENT); }
__device__ __forceinline__ unsigned xb_xcc_id() { return (unsigned)__builtin_amdgcn_s_getreg((3 << 11) | 20) & 0xFu; }
#define XB_SPIN(cond, bar) do { unsigned _sp = 0; while (cond) { __builtin_amdgcn_s_sleep(1); \
    if ((++_sp & 255u) == 0u) { if (xb_ld(&(bar)[XB_TMO])) break; if (_sp > XB_SPIN_CAP) { atomicAdd(&(bar)[XB_TMO], 1u); break; } } } } while (0)

struct XcdBarrier {
    unsigned* bar; unsigned x;
    volatile LAS unsigned* st;
};

__device__ __forceinline__ XcdBarrier xcd_barrier_post(unsigned* bar, volatile LAS unsigned* st) {
    XcdBarrier b; b.bar = bar; b.x = xb_xcc_id(); b.st = st;
    if (threadIdx.x == 0) (void)xb_add(&bar[XB_XCNT(b.x)], 1u);
    return b;
}
__device__ __forceinline__ void xcd_barrier_complete(unsigned* bar, unsigned x, unsigned& nloc, unsigned& nx) {
    const unsigned G = gridDim.x * gridDim.y * gridDim.z;
    unsigned sum, cnt, mine, sp = 0u;
    for (;;) {
        sum = 0u; cnt = 0u; mine = 0u;
#pragma unroll
        for (unsigned j = 0; j < 16; ++j) { const unsigned c = xb_ld(&bar[XB_XCNT(j)]); sum += c; cnt += (c > 0u) ? 1u : 0u; mine = (j == x) ? c : mine; }
        if (sum == G) break;
        __builtin_amdgcn_s_sleep(1);
        if ((++sp & 255u) == 0u) { if (xb_ld(&bar[XB_TMO])) break; if (sp > XB_SPIN_CAP) { atomicAdd(&bar[XB_TMO], 1u); break; } }
    }
    nloc = mine > 0u ? mine : 1u; nx = cnt > 0u ? cnt : 1u;
}

__device__ __forceinline__ void xcd_barrier(const XcdBarrier& b) {
    asm volatile("s_waitcnt vmcnt(0)" ::: "memory");
    __syncthreads();
    if (threadIdx.x == 0) {
        unsigned* bar = b.bar;
        __builtin_amdgcn_s_waitcnt(0);
        unsigned nloc = b.st[0], nx = b.st[1];
        if (nloc == 0u) { xcd_barrier_complete(bar, b.x, nloc, nx); b.st[0] = nloc; b.st[1] = nx; }
        const unsigned old = xb_add(&bar[XB_XSUB(b.x)], 1u);
        const unsigned gen = old / nloc;
        if (old + 1u == (gen + 1u) * nloc) {
            __builtin_amdgcn_fence(__ATOMIC_RELEASE, "agent");
            asm volatile("s_waitcnt vmcnt(0)" ::: "memory");
            const unsigned og = xb_add(&bar[XB_TOP], 1u);
            const unsigned tg = og / nx;
            if (og + 1u == (tg + 1u) * nx) xb_add(&bar[XB_TOPGEN], 1u);
            else XB_SPIN(xb_ld(&bar[XB_TOPGEN]) == tg, bar);
            __builtin_amdgcn_fence(__ATOMIC_ACQUIRE, "agent");
            xb_add(&bar[XB_XGEN(b.x)], 1u);
            asm volatile("s_waitcnt vmcnt(0)" ::: "memory");
        } else {
            XB_SPIN(xb_ld(&bar[XB_XGEN(b.x)]) == gen, bar);
            __builtin_amdgcn_fence(__ATOMIC_ACQUIRE, "agent");
            asm volatile("s_waitcnt vmcnt(0)" ::: "memory");
        }
    }
    __syncthreads();
}

__device__ __forceinline__ float wave_sum(float v) {
#pragma unroll
    for (int o = 1; o < 64; o <<= 1) v += __shfl_xor(v, o);
    return v;
}
__device__ __forceinline__ void p0_transpose_item(const float* W, int K, int N, bf16* WT, int row_off, LAS float* scr, int item, int lane) {
    const int nblk = N / 32, kb = item / nblk, nb = item % nblk, k0 = 64 * kb, n0 = 32 * nb;
#pragma unroll 8
    for (int i = 0; i < 32; ++i) { const int kk = 2 * i + (lane >> 5); scr[kk * 33 + (lane & 31)] = W[(size_t)(k0 + kk) * N + n0 + (lane & 31)]; }
    LDS_WAIT(); asm volatile("" ::: "memory");
    const int c = lane & 7;
#pragma unroll
    for (int j = 0; j < 4; ++j) { const int n = (lane >> 3) + 8 * j; const LAS float* s = scr + (8 * c) * 33 + n;
        v4u o; o.x = pk2(s[0 * 33], s[1 * 33]); o.y = pk2(s[2 * 33], s[3 * 33]); o.z = pk2(s[4 * 33], s[5 * 33]); o.w = pk2(s[6 * 33], s[7 * 33]);
        *(GAS v4u*)(WT + (size_t)(row_off + n0 + n) * K + k0 + 8 * c) = o; }
    LDS_WAIT(); asm volatile("" ::: "memory");
}

constexpr int DM = 1024, NP = 16384, NSM = 1024, MT = NP + NSM;
constexpr int SEQ = 2048, NDB = 128, WBUF = 2048;
constexpr int INW = 3328, RIN = 1792, AW = 512, DFF = 4096, HD = 64;
constexpr int MODW = 6144;
constexpr float NORM_EPS = 1e-6f, LNX_EPS = 64e-5f;
constexpr float QC2 = 0.125f * 1.4426950408889634f;
constexpr int NWAVES = 8;

constexpr size_t MiB = 1u << 20;
constexpr size_t WS_CTL = 0, CTL_ZERO_BYTES = 1 * MiB;
constexpr size_t WS_WIN = 2 * MiB, WS_WOUT = 9 * MiB, WS_WFF1 = 11 * MiB, WS_WFF2 = 19 * MiB, WS_WADA = 27 * MiB;
constexpr size_t WS_SILU = 39 * MiB, WS_ROPE = 40 * MiB, WS_LW2 = 41 * MiB, WS_LA2 = 41 * MiB + 65536, WS_LG2 = 41 * MiB + 131072;
constexpr size_t WS_MOD = 42 * MiB, WS_H = 48 * MiB, WS_Q = 82 * MiB, WS_K = 99 * MiB, WS_V = 116 * MiB, WS_P = 133 * MiB;
constexpr size_t WS_DEC = 252 * MiB, WS_KP = 286 * MiB, WS_KK = 320 * MiB, WS_KKA = 354 * MiB, WS_G = 388 * MiB, WS_BON = 422 * MiB;
constexpr size_t WS_SOUT = 423 * MiB, WS_APART = 457 * MiB, WS_LSE = 508 * MiB, WS_MIX = 510 * MiB, WS_X1 = 544 * MiB, WS_U = 612 * MiB, WS_X2 = 748 * MiB, WS_R = 816 * MiB, WS_VL = 850 * MiB, WS_END = 884 * MiB;
constexpr int CW_BAR = 4096, CW_Q5 = 64, CW_Q4 = 1024;
constexpr size_t ZROW_OFF = 524288;
constexpr size_t O_YP = 0, O_YS = 16777216, O_KP = 17825792, O_VP = 26214400, O_WKVP = 34603008, O_SHP = 34865152, O_KS = 34879488, O_VS = 35403776, O_WKVS = 35928064, O_SHS = 40122368, O_END = 40351744;

constexpr int RING_OFF = 0, RING_BYTES = 131072;
constexpr int LDSCTL_OFF = RING_BYTES, MISC_OFF = LDSCTL_OFF + 320;
constexpr int LDS_BYTES = 147456;

struct KP { const float* in[28]; float* out; unsigned char* ws; };

typedef float f32x16 __attribute__((ext_vector_type(16)));
typedef float f32x2 __attribute__((ext_vector_type(2)));
typedef short s16x4 __attribute__((ext_vector_type(4)));
#define NEG_INF (-__builtin_inff())
#define MFMA32(a, b, c) __builtin_amdgcn_mfma_f32_32x32x16_bf16((a), (b), (c), 0, 0, 0)
__device__ __forceinline__ int crow(int r, int hi) { return (r & 3) + 8 * (r >> 2) + 4 * hi; }
using pg8::cvt_pk_bf16;
__device__ __forceinline__ bf16x8 pack8(float a0, float a1, float a2, float a3, float a4, float a5, float a6, float a7) {
    v4u w; w.x = cvt_pk_bf16(a0, a1); w.y = cvt_pk_bf16(a2, a3); w.z = cvt_pk_bf16(a4, a5); w.w = cvt_pk_bf16(a6, a7); return __builtin_bit_cast(bf16x8, w); }
__device__ __forceinline__ float bf2f(unsigned short b) { return __builtin_bit_cast(float, (unsigned)b << 16); }
template <int CTRL> __device__ __forceinline__ float dpp(float x) { return __builtin_bit_cast(float, __builtin_amdgcn_mov_dpp(__builtin_bit_cast(int, x), CTRL, 0xf, 0xf, true)); }
__device__ __forceinline__ float sum4(float x) { x += dpp<0xB1>(x); x += dpp<0x4E>(x); return x; }
__device__ __forceinline__ float sum8(float x) { x = sum4(x); x += dpp<0x141>(x); return x; }
__device__ __forceinline__ float sum16(float x) { x = sum8(x); x += dpp<0x128>(x); return x; }
__device__ __forceinline__ float sum32(float x) { x = sum16(x); x += __shfl_xor(x, 16); return x; }
__device__ __forceinline__ float fexp_(float x) { return __builtin_amdgcn_exp2f(x * 1.4426950408889634f); }
__device__ __forceinline__ float sigmoidf_(float x) { return __builtin_amdgcn_rcpf(1.0f + fexp_(-x)); }
__device__ __forceinline__ float tanhf_(float x) { return 1.0f - 2.0f * __builtin_amdgcn_rcpf(1.0f + fexp_(2.0f * x)); }
__device__ __forceinline__ int modrow(int m) { return m < NP ? (m >> 11) : 8 + ((m - NP) >> 3); }

__device__ __forceinline__ void p0_prologue(const KP& p, LAS unsigned char* lds, int vcu, int G, int tid) {
    const int wave = __builtin_amdgcn_readfirstlane(tid >> 6), lane = tid & 63;
    LAS float* scr = (LAS float*)(lds + RING_OFF + wave * 16384);
    const int gw = vcu * NWAVES + wave, NGW = G * NWAVES;
    constexpr int I_IN = (DM / 64) * (INW / 32), I_OUT = (DM / 64) * (DM / 32), I_F1 = (DM / 64) * (DFF / 32), I_F2 = (DFF / 64) * (DM / 32), I_ADA = (DM / 64) * (MODW / 32);
    constexpr int NITEMS = I_IN + I_OUT + I_F1 + I_F2 + I_ADA;
    for (int it = gw; it < NITEMS; it += NGW) {
        int r = it;
        if (r < I_IN) { p0_transpose_item(p.in[12], DM, INW, (bf16*)(p.ws + WS_WIN), 0, scr, r, lane); continue; } r -= I_IN;
        if (r < I_OUT) { p0_transpose_item(p.in[13], DM, DM, (bf16*)(p.ws + WS_WOUT), 0, scr, r, lane); continue; } r -= I_OUT;
        if (r < I_F1) { p0_transpose_item(p.in[25], DM, DFF, (bf16*)(p.ws + WS_WFF1), 0, scr, r, lane); continue; } r -= I_F1;
        if (r < I_F2) { p0_transpose_item(p.in[26], DFF, DM, (bf16*)(p.ws + WS_WFF2), 0, scr, r, lane); continue; } r -= I_F2;
        p0_transpose_item(p.in[10], DM, MODW, (bf16*)(p.ws + WS_WADA), 0, scr, r, lane);
    }
    const int gt = vcu * (NWAVES * 64) + tid, NGT = G * NWAVES * 64;
    for (int g = gt; g < 256 * 256; g += NGT) { const int row = g >> 8, c4 = (g & 255) * 4;
        f32x4 c = {0.f, 0.f, 0.f, 0.f};
        if (row < 8) c = *(const f32x4*)(p.in[6] + (size_t)row * DM + c4); else if (row < 136) c = *(const f32x4*)(p.in[7] + (size_t)(row - 8) * DM + c4);
        f32x4 s; for (int e = 0; e < 4; ++e) s[e] = c[e] / (1.0f + expf(-c[e]));
        unsigned long long o = (unsigned long long)cvt_pk_bf16(s[0], s[1]) | ((unsigned long long)cvt_pk_bf16(s[2], s[3]) << 32);
        *(unsigned long long*)((bf16*)(p.ws + WS_SILU) + (size_t)row * DM + c4) = o; }
    for (int e = gt; e < 2056 * 8; e += NGT) { const int idx = e >> 3, i = e & 7; const int pos = idx < 2048 ? idx : 8192 + (idx - 2048);
        const double inv = exp(-(double)i * (0.125 * 13.122363377404328));
        const double ang = (double)pos * inv; const double k = rint(ang * 0.15915494309189535); const float rr = (float)(ang - k * 6.283185307179586);
        float* t = (float*)(p.ws + WS_ROPE) + (size_t)idx * 16; t[i] = cosf(rr); t[8 + i] = sinf(rr); }
    for (int e = gt; e < 16384; e += NGT) {
        const float* W; bf16x8* dst; int KS, r = e;
        if (r < 4096) { W = p.in[16]; dst = (bf16x8*)(p.ws + WS_LW2); KS = 4; } else if (r < 8192) { r -= 4096; W = p.in[18]; dst = (bf16x8*)(p.ws + WS_LA2); KS = 4; } else { r -= 8192; W = p.in[19]; dst = (bf16x8*)(p.ws + WS_LG2); KS = 8; }
        const int ln = r & 63, fk = r >> 6, nt = fk / KS, ks = fk % KS; const int n = 32 * nt + (ln & 31), k0 = 16 * ks + 8 * (ln >> 5);
        float w[8]; for (int j = 0; j < 8; ++j) w[j] = W[(size_t)(k0 + j) * 512 + n];
        dst[r] = pack8(w[0], w[1], w[2], w[3], w[4], w[5], w[6], w[7]); }
}

__device__ __forceinline__ void norm_mod_rows(const float* x0, const float* x1, const float* gain, const float* mod, int sh_off, int sc_off, bf16* H, int vcu, int G, int tid) {
    const int wave = __builtin_amdgcn_readfirstlane(tid >> 6), lane = tid & 63, gw = vcu * NWAVES + wave, NGW = G * NWAVES;
    for (int m = gw; m < MT; m += NGW) {
        const float* xr = m < NP ? x0 + (size_t)m * DM : x1 + (size_t)(m - NP) * DM;
        const GAS f32x4* xv = (const GAS f32x4*)xr + lane;
        f32x4 v[4]; float s = 0.f;
#pragma unroll
        for (int j = 0; j < 4; ++j) { v[j] = xv[64 * j]; s += (v[j].x * v[j].x + v[j].y * v[j].y) + (v[j].z * v[j].z + v[j].w * v[j].w); }
        const float rstd = 1.0f / sqrtf(wave_sum(s) * (1.0f / DM) + NORM_EPS);
        const float* mr = mod + (size_t)modrow(m) * MODW;
        GAS unsigned long long* o8 = (GAS unsigned long long*)(H + (size_t)m * DM) + lane;
#pragma unroll
        for (int j = 0; j < 4; ++j) { const int c = 4 * lane + 256 * j;
            const f32x4 g = *(const f32x4*)(gain + c), sc = *(const f32x4*)(mr + sc_off + c), sh = *(const f32x4*)(mr + sh_off + c);
            const f32x4 o = v[j] * rstd * g * (sc + 1.0f) + sh;
            o8[64 * j] = (unsigned long long)cvt_pk_bf16(o.x, o.y) | ((unsigned long long)cvt_pk_bf16(o.z, o.w) << 32); }
    }
}
__device__ __forceinline__ void final_norm_rows(const float* X, const float* gain, float* out, int vcu, int G, int tid) {
    const int wave = __builtin_amdgcn_readfirstlane(tid >> 6), lane = tid & 63, gw = vcu * NWAVES + wave, NGW = G * NWAVES;
    for (int m = gw; m < MT; m += NGW) {
        const GAS f32x4* xv = (const GAS f32x4*)(X + (size_t)m * DM) + lane;
        f32x4 v[4]; float s = 0.f;
#pragma unroll
        for (int j = 0; j < 4; ++j) { v[j] = xv[64 * j]; s += (v[j].x * v[j].x + v[j].y * v[j].y) + (v[j].z * v[j].z + v[j].w * v[j].w); }
        const float rstd = 1.0f / sqrtf(wave_sum(s) * (1.0f / DM) + NORM_EPS);
        GAS f32x4* ov = (GAS f32x4*)(out + (size_t)m * DM) + lane;
#pragma unroll
        for (int j = 0; j < 4; ++j) { const f32x4 g = *(const f32x4*)(gain + 4 * lane + 256 * j); ov[64 * j] = v[j] * rstd * g; }
    }
}

constexpr int VP = 144;
constexpr int WLDS = 32 * VP + 256;
#define TRR(dst, off) asm volatile("ds_read_b64_tr_b16 %0, %1 offset:%c2" : "=&v"(dst) : "v"(vb), "i"(off) : "memory")
__device__ __forceinline__ void attn_prompt_task(const KP& p, int tk, LAS unsigned char* wl, int lane) {
    const bf16* Q = (const bf16*)(p.ws + WS_Q); const bf16* K = (const bf16*)(p.ws + WS_K); const bf16* V = (const bf16*)(p.ws + WS_V);
    const int bh = tk / 192, rem = tk % 192, unit = rem >> 2, qt = rem & 3, b = bh >> 3, h = bh & 7;
    int br, dil, cls, nb;
    if (unit < 16) { br = 0; dil = 1; cls = 0; nb = unit; } else if (unit < 32) { br = 1; dil = 4; cls = (unit - 16) & 3; nb = (unit - 16) >> 2; } else { br = 2; dil = 16; cls = unit - 32; nb = 0; }
    const int r32 = lane & 31, hi = lane >> 5, m0 = nb * 128 + qt * 32;
    const size_t rowb = (size_t)b * SEQ;
    const int pq = (m0 + r32) * dil + cls;
    bf16x8 qr[4];
    { const bf16* qp = Q + (rowb + pq) * AW + h * HD + hi * 8;
#pragma unroll
      for (int d0 = 0; d0 < 4; ++d0) qr[d0] = *(const bf16x8*)(qp + d0 * 16); }
    const int kt_lo = (nb == 0) ? 4 - qt : 0;
    bf16x8 kf[5][4];
#pragma unroll
    for (int kt = 0; kt < 5; ++kt) {
        const int kidx = m0 - 128 + 32 * kt + r32; const int pk = (kidx < 0 ? 0 : kidx) * dil + cls;
        const bf16* kp = K + (rowb + pk) * AW + h * HD + hi * 8;
#pragma unroll
        for (int d0 = 0; d0 < 4; ++d0) kf[kt][d0] = *(const bf16x8*)(kp + d0 * 16);
    }
    f32x16 S[5];
#pragma unroll
    for (int kt = 0; kt < 5; ++kt) {
        f32x16 a;
#pragma unroll
        for (int r = 0; r < 16; ++r) a[r] = 0.f;
#pragma unroll
        for (int d0 = 0; d0 < 4; ++d0) a = MFMA32(kf[kt][d0], qr[d0], a);
        if (kt < kt_lo) {
#pragma unroll
            for (int r = 0; r < 16; ++r) a[r] = NEG_INF;
        }
        if (kt == 0) {
#pragma unroll
            for (int r = 0; r < 16; ++r) if (crow(r, hi) < r32) a[r] = NEG_INF;
        }
        if (kt == 4) {
#pragma unroll
            for (int r = 0; r < 16; ++r) if (crow(r, hi) > r32) a[r] = NEG_INF;
        }
        S[kt] = a;
    }
    v4u vv[5][4];
#pragma unroll
    for (int kt = 0; kt < 5; ++kt)
#pragma unroll
        for (int i = 0; i < 4; ++i) { const int rr = (lane >> 3) + 8 * i, ch = lane & 7; const int kidx = m0 - 128 + 32 * kt + rr; const int pk = (kidx < 0 ? 0 : kidx) * dil + cls;
            vv[kt][i] = *(const v4u*)(V + (rowb + pk) * AW + h * HD + ch * 8); }
    float mx = NEG_INF;
#pragma unroll
    for (int kt = 0; kt < 5; ++kt)
#pragma unroll
        for (int r = 0; r < 16; ++r) mx = fmaxf(mx, S[kt][r]);
    mx = fmaxf(mx, __shfl_xor(mx, 32));
    float l = 0.f;
#pragma unroll
    for (int kt = 0; kt < 5; ++kt)
#pragma unroll
        for (int r = 0; r < 16; ++r) { const float e = __builtin_amdgcn_exp2f(S[kt][r] - mx); S[kt][r] = e; l += e; }
    l += __shfl_xor(l, 32);
    f32x16 o0, o1;
#pragma unroll
    for (int r = 0; r < 16; ++r) { o0[r] = 0.f; o1[r] = 0.f; }
    const int i16 = lane & 15, q4 = i16 >> 2, p4 = i16 & 3, g16 = (lane >> 4) & 1;
    const unsigned vb = (unsigned)(uintptr_t)wl + (unsigned)((4 * hi + q4) * VP + 32 * g16 + 8 * p4);
#pragma unroll
    for (int kt = 0; kt < 5; ++kt) {
        if (kt >= kt_lo) {
#pragma unroll
            for (int i = 0; i < 4; ++i) { const int rr = (lane >> 3) + 8 * i, ch = lane & 7; *(LAS v4u*)(wl + rr * VP + ch * 16) = vv[kt][i]; }
            const bf16x8 pa0 = pack8(S[kt][0], S[kt][1], S[kt][2], S[kt][3], S[kt][4], S[kt][5], S[kt][6], S[kt][7]);
            const bf16x8 pa1 = pack8(S[kt][8], S[kt][9], S[kt][10], S[kt][11], S[kt][12], S[kt][13], S[kt][14], S[kt][15]);
            s16x4 t00l, t00h, t01l, t01h, t10l, t10h, t11l, t11h;
            asm volatile("s_waitcnt lgkmcnt(0)" ::: "memory");
            TRR(t00l, 0);                 TRR(t00h, 8 * VP);
            TRR(t01l, 64);                TRR(t01h, 8 * VP + 64);
            TRR(t10l, 16 * VP);           TRR(t10h, 24 * VP);
            TRR(t11l, 16 * VP + 64);      TRR(t11h, 24 * VP + 64);
            asm volatile("s_waitcnt lgkmcnt(0)" ::: "memory");
            __builtin_amdgcn_sched_barrier(0);
#define PKV(lo, hi_) (bf16x8){lo[0], lo[1], lo[2], lo[3], hi_[0], hi_[1], hi_[2], hi_[3]}
            o0 = MFMA32(pa0, PKV(t00l, t00h), o0); o1 = MFMA32(pa0, PKV(t01l, t01h), o1);
            o0 = MFMA32(pa1, PKV(t10l, t10h), o0); o1 = MFMA32(pa1, PKV(t11l, t11h), o1);
#undef PKV
        }
    }
    LAS float* ls = (LAS float*)(wl + 32 * VP);
    if (hi == 0) ls[r32] = l;
    asm volatile("s_waitcnt lgkmcnt(0)" ::: "memory");
    float rl[16];
#pragma unroll
    for (int r = 0; r < 16; ++r) rl[r] = 1.0f / ls[crow(r, hi)];
    LAS unsigned short* stg = (LAS unsigned short*)wl;
#pragma unroll
    for (int r = 0; r < 16; ++r) { const int orow = crow(r, hi);
        stg[orow * 64 + r32] = (unsigned short)(cvt_pk_bf16(o0[r] * rl[r], 0.f) & 0xffffu);
        stg[orow * 64 + 32 + r32] = (unsigned short)(cvt_pk_bf16(o1[r] * rl[r], 0.f) & 0xffffu); }
    asm volatile("s_waitcnt lgkmcnt(0)" ::: "memory");
    bf16* AP = (bf16*)(p.ws + WS_APART) + (size_t)br * MT * AW;
#pragma unroll
    for (int i = 0; i < 4; ++i) { const int row = i * 8 + (lane >> 3), ch = lane & 7; const v4u v = *(const LAS v4u*)(stg + row * 64 + ch * 8);
        const int pr = (m0 + row) * dil + cls; *(v4u*)(AP + (rowb + pr) * AW + h * HD + ch * 8) = v; }
    if (hi == 0) { float* L = (float*)(p.ws + WS_LSE) + (size_t)br * MT * 8; L[(rowb + pq) * 8 + h] = mx + __builtin_amdgcn_logf(l); }
    asm volatile("s_waitcnt lgkmcnt(0)" ::: "memory");
}

template <int ACT> __device__ __forceinline__ bf16x8 prep_afrag(const float* pr, const float* pp, const float* mu, int c) {
    float x[8];
#pragma unroll
    for (int q = 0; q < 2; ++q) { const f32x4 a = *(const f32x4*)(pr + c + 4 * q), bq = *(const f32x4*)(pp + c + 4 * q), mq = *(const f32x4*)(mu + c + 4 * q); const f32x4 y = a + (bq - a) * mq;
        x[4 * q] = y.x; x[4 * q + 1] = y.y; x[4 * q + 2] = y.z; x[4 * q + 3] = y.w; }
    if (ACT == 1) {
#pragma unroll
        for (int j = 0; j < 8; ++j) x[j] = tanhf_(x[j]); }
    if (ACT == 2) {
#pragma unroll
        for (int j = 0; j < 8; ++j) x[j] = sigmoidf_(x[j]); }
    return pack8(x[0], x[1], x[2], x[3], x[4], x[5], x[6], x[7]);
}
__device__ __forceinline__ const float* prev_row(const KP& p, const float* P, int m) {
    if (m < NP) return (m & 2047) == 0 ? (const float*)(p.ws + WS_CTL + ZROW_OFF) : P + (size_t)(m - 1) * RIN;
    const int ms = m - NP; return (ms & 7) == 0 ? p.in[5] + (size_t)(ms >> 3) * RIN : P + (size_t)(m - 1) * RIN;
}
constexpr int LA_PITCH = 272;
__device__ __forceinline__ void prep_a_task(const KP& p, int tg, int hh, LAS unsigned char* wl, int lane) {
    const int r32 = lane & 31, hi = lane >> 5;
    const float* P = (const float*)(p.ws + WS_P); const float* mu = p.in[14];
    bf16x8 aa[4];
    { const int m = 32 * tg + r32; const float* pr = P + (size_t)m * RIN; const float* pp = prev_row(p, P, m);
#pragma unroll
      for (int ks = 0; ks < 4; ++ks) aa[ks] = prep_afrag<0>(pr, pp, mu, 1600 + 16 * ks + 8 * hi); }
    const bf16x8* LA2 = (const bf16x8*)(p.ws + WS_LA2);
    float* KPo = (float*)(p.ws + WS_KP); float* KKo = (float*)(p.ws + WS_KK); float* KKAo = (float*)(p.ws + WS_KKA); float* BON = (float*)(p.ws + WS_BON); float* Ro = (float*)(p.ws + WS_R); float* VLo = (float*)(p.ws + WS_VL);
    f32x16 d0, d1;
#pragma unroll
    for (int r = 0; r < 16; ++r) { d0[r] = 0.f; d1[r] = 0.f; }
#pragma unroll
    for (int ks = 0; ks < 4; ++ks) { d0 = MFMA32(aa[ks], LA2[((2 * hh) * 4 + ks) * 64 + lane], d0); d1 = MFMA32(aa[ks], LA2[((2 * hh + 1) * 4 + ks) * 64 + lane], d1); }
#pragma unroll
    for (int r = 0; r < 16; ++r) { LAS float* row = (LAS float*)(wl + crow(r, hi) * LA_PITCH); row[r32] = d0[r]; row[32 + r32] = d1[r]; }
    asm volatile("s_waitcnt lgkmcnt(0)" ::: "memory");
    const int tq = lane >> 4, ch4 = lane & 15, c = 64 * hh + 4 * ch4;
    const f32x4 muk = *(const f32x4*)(mu + 512 + c), mur = *(const f32x4*)(mu + c), muv = *(const f32x4*)(mu + 1024 + c);
    const f32x4 a0q = *(const f32x4*)(p.in[17] + c), kkq = *(const f32x4*)(p.in[20] + c), kaq = *(const f32x4*)(p.in[21] + c), rkq = *(const f32x4*)(p.in[22] + c);
#pragma unroll 4
    for (int it = 0; it < 8; ++it) { const int t = 4 * it + tq, m = 32 * tg + t;
        const float* pr = P + (size_t)m * RIN + c; const float* pp = prev_row(p, P, m) + c;
        const f32x4 kx = *(const f32x4*)(pr + 512), ky = *(const f32x4*)(pp + 512), rx = *(const f32x4*)(pr), ry = *(const f32x4*)(pp), vx = *(const f32x4*)(pr + 1024), vy = *(const f32x4*)(pp + 1024);
        const f32x4 aL = *(const LAS f32x4*)(wl + t * LA_PITCH + ch4 * 16);
        const f32x4 kl = kx + (ky - kx) * muk, rl = rx + (ry - rx) * mur, vl = vx + (vy - vx) * muv, kr = kl * kkq;
        const float n2 = sum16((kr.x * kr.x + kr.y * kr.y) + (kr.z * kr.z + kr.w * kr.w));
        const float rn = 1.0f / fmaxf(sqrtf(n2), 1e-12f);
        f32x4 av; av.x = sigmoidf_(a0q.x + aL.x); av.y = sigmoidf_(a0q.y + aL.y); av.z = sigmoidf_(a0q.z + aL.z); av.w = sigmoidf_(a0q.w + aL.w);
        const f32x4 kp = kl * ((av - 1.0f) * kaq + 1.0f), kn = kr * rn, bq = rl * kp * rkq;
        const float bn = sum16((bq.x + bq.y) + (bq.z + bq.w));
        const size_t ob = (size_t)m * AW + c;
        *(f32x4*)(KPo + ob) = kp; *(f32x4*)(KKo + ob) = kn; *(f32x4*)(KKAo + ob) = -(kn * av);
        *(f32x4*)(Ro + ob) = rl; *(f32x4*)(VLo + ob) = vl;
        if (ch4 == 0) BON[(size_t)m * 8 + hh] = bn; }
    asm volatile("s_waitcnt lgkmcnt(0)" ::: "memory");
}
__device__ __forceinline__ void prep_w_task(const KP& p, int tg, int hp, int lane) {
    const int r32 = lane & 31, hi = lane >> 5;
    const float* P = (const float*)(p.ws + WS_P); const float* mu = p.in[14];
    bf16x8 aw[4];
    { const int m = 32 * tg + r32; const float* pr = P + (size_t)m * RIN; const float* pp = prev_row(p, P, m);
#pragma unroll
      for (int ks = 0; ks < 4; ++ks) aw[ks] = prep_afrag<1>(pr, pp, mu, 1536 + 16 * ks + 8 * hi); }
    const bf16x8* LW2 = (const bf16x8*)(p.ws + WS_LW2); float* DEC = (float*)(p.ws + WS_DEC); const float* w0 = p.in[15];
#pragma unroll 1
    for (int nt = 4 * hp; nt < 4 * hp + 4; ++nt) { const int c = 32 * nt + r32;
        f32x16 d;
#pragma unroll
        for (int r = 0; r < 16; ++r) d[r] = 0.f;
#pragma unroll
        for (int ks = 0; ks < 4; ++ks) d = MFMA32(aw[ks], LW2[(nt * 4 + ks) * 64 + lane], d);
        const float w0c = w0[c];
#pragma unroll
        for (int r = 0; r < 16; ++r) DEC[(size_t)(32 * tg + crow(r, hi)) * AW + c] = fexp_(-0.6065306597126334f * sigmoidf_(w0c + d[r])); }
}
__device__ __forceinline__ void prep_g_task(const KP& p, int tg, int hp, int lane) {
    const int r32 = lane & 31, hi = lane >> 5;
    const float* P = (const float*)(p.ws + WS_P); const float* mu = p.in[14];
    bf16x8 ag[8];
    { const int m = 32 * tg + r32; const float* pr = P + (size_t)m * RIN; const float* pp = prev_row(p, P, m);
#pragma unroll
      for (int ks = 0; ks < 8; ++ks) ag[ks] = prep_afrag<2>(pr, pp, mu, 1664 + 16 * ks + 8 * hi); }
    const bf16x8* LG2 = (const bf16x8*)(p.ws + WS_LG2); float* Go = (float*)(p.ws + WS_G);
#pragma unroll 1
    for (int nt = 4 * hp; nt < 4 * hp + 4; ++nt) { const int c = 32 * nt + r32;
        f32x16 d;
#pragma unroll
        for (int r = 0; r < 16; ++r) d[r] = 0.f;
#pragma unroll
        for (int ks = 0; ks < 8; ++ks) d = MFMA32(ag[ks], LG2[(nt * 8 + ks) * 64 + lane], d);
#pragma unroll
        for (int r = 0; r < 16; ++r) Go[(size_t)(32 * tg + crow(r, hi)) * AW + c] = d[r]; }
}
constexpr int NTG = MT / 32, NT_PREP = 10 * NTG;

constexpr int TC = 32, SC_ARR = TC * 64 * 4, SCB = 5 * SC_ARR + TC * 16 * 4, NBUF = 3, NCH = SEQ / TC;
static_assert(NBUF * SCB <= RING_BYTES, "scan ring fits the LDS ring region");
__device__ __forceinline__ unsigned lds_ld(unsigned addr) { unsigned v; asm volatile("ds_read_b32 %0, %1\n\ts_waitcnt lgkmcnt(0)" : "=v"(v) : "v"(addr) : "memory"); return v; }
__device__ __forceinline__ void lds_st(unsigned addr, unsigned v) { asm volatile("ds_write_b32 %0, %1" :: "v"(addr), "v"(v) : "memory"); }
__device__ __forceinline__ void scan_block(const KP& p, LAS unsigned char* lds, unsigned sw, int wave, int lane, int G, int vcu) {
    const float* DEC = (const float*)(p.ws + WS_DEC); const float* KPi = (const float*)(p.ws + WS_KP); const float* KKi = (const float*)(p.ws + WS_KK); const float* KKAi = (const float*)(p.ws + WS_KKA);
    const float* Ri = (const float*)(p.ws + WS_R); const float* VLi = (const float*)(p.ws + WS_VL); float* SO = (float*)(p.ws + WS_SOUT);
    unsigned gc = 0;
#pragma unroll 1
    for (int item = vcu; item < 256; item += G) {
        const int b = item >> 5, h = (item >> 2) & 7, qr = item & 3; const size_t rowb = (size_t)b * SEQ;
        if (wave == 4) {
            const size_t la = (size_t)(lane >> 4) * AW + h * HD + 4 * (lane & 15), lv = (size_t)(lane >> 2) * AW + h * HD + 16 * qr + 4 * (lane & 3);
#pragma unroll 1
            for (int c = 0; c < NCH; ++c, ++gc) {
                if (gc >= (unsigned)NBUF) { const unsigned need = gc - NBUF + 1; unsigned sp = 0;
                    for (;;) { const unsigned d0 = lds_ld(sw + 16), d1 = lds_ld(sw + 20), d2 = lds_ld(sw + 24), d3 = lds_ld(sw + 28);
                        const unsigned mn = min(min(d0, d1), min(d2, d3)); if (mn >= need) break;
                        __builtin_amdgcn_s_sleep(2); if (++sp > (1u << 22)) { lds_st(sw + 64, 1u); break; } } }
                LAS unsigned char* buf = lds + (gc % NBUF) * SCB; const size_t m0 = (rowb + (size_t)c * TC) * AW;
#pragma unroll
                for (int i = 0; i < 8; ++i) { const size_t o = m0 + (size_t)(4 * i) * AW + la;
                    __builtin_amdgcn_global_load_lds((const unsigned*)(DEC + o), (LAS unsigned*)(buf + 0 * SC_ARR + i * 1024), 16, 0, 0);
                    __builtin_amdgcn_global_load_lds((const unsigned*)(KPi + o), (LAS unsigned*)(buf + 1 * SC_ARR + i * 1024), 16, 0, 0);
                    __builtin_amdgcn_global_load_lds((const unsigned*)(KKi + o), (LAS unsigned*)(buf + 2 * SC_ARR + i * 1024), 16, 0, 0);
                    __builtin_amdgcn_global_load_lds((const unsigned*)(KKAi + o), (LAS unsigned*)(buf + 3 * SC_ARR + i * 1024), 16, 0, 0);
                    __builtin_amdgcn_global_load_lds((const unsigned*)(Ri + o), (LAS unsigned*)(buf + 4 * SC_ARR + i * 1024), 16, 0, 0); }
#pragma unroll
                for (int i = 0; i < 2; ++i) __builtin_amdgcn_global_load_lds((const unsigned*)(VLi + m0 + (size_t)(16 * i) * AW + lv), (LAS unsigned*)(buf + 5 * SC_ARR + i * 1024), 16, 0, 0);
                if (c >= 1) { asm volatile("s_waitcnt vmcnt(42)" ::: "memory"); lds_st(sw, gc); }
            }
            asm volatile("s_waitcnt vmcnt(0)" ::: "memory"); lds_st(sw, gc);
        } else {
            const int il = lane >> 4, js = lane & 15, irow = 4 * wave + il;
            f32x4 S = {0.f, 0.f, 0.f, 0.f};
            float* so = SO + rowb * AW + h * HD + 16 * qr + irow;
#pragma unroll 1
            for (int c = 0; c < NCH; ++c, ++gc) {
                { unsigned sp = 0; while (lds_ld(sw) < gc + 1u) { __builtin_amdgcn_s_sleep(1); if (++sp > (1u << 22)) { lds_st(sw + 64, 1u); break; } } }
                const LAS unsigned char* buf = lds + (gc % NBUF) * SCB + js * 16; const LAS unsigned char* vbuf = lds + (gc % NBUF) * SCB + 5 * SC_ARR + irow * 4;
#define SC_LD(T_, W, KP_, KK_, KN_, RV_, VV_) do { const LAS unsigned char* b_ = buf + (T_) * 256; W = *(const LAS f32x4*)(b_); KP_ = *(const LAS f32x4*)(b_ + SC_ARR); KK_ = *(const LAS f32x4*)(b_ + 2 * SC_ARR); \
        KN_ = *(const LAS f32x4*)(b_ + 3 * SC_ARR); RV_ = *(const LAS f32x4*)(b_ + 4 * SC_ARR); VV_ = *(const LAS float*)(vbuf + (T_) * 64); } while (0)
                f32x4 w, kp, kk, kn, rv; float vv;
                SC_LD(0, w, kp, kk, kn, rv, vv);
#pragma unroll
                for (int g = 0; g < TC / 16; ++g) {
                    float oacc = 0.f, op = 0.f;
#pragma unroll
                    for (int u = 0; u < 16; ++u) { const int t = 16 * g + u;
                        f32x4 wn = w, kpn = kp, kkn = kk, knn = kn, rvn = rv; float vvn = vv;
                        if (t + 1 < TC) SC_LD(t + 1, wn, kpn, kkn, knn, rvn, vvn);
                        float d = (S.x * kk.x + S.y * kk.y) + (S.z * kk.z + S.w * kk.w);
                        const f32x4 T = S * w + kp * vv;
                        d += dpp<0xB1>(d); if (u > 0) op += dpp<0xB1>(op);
                        d += dpp<0x4E>(d); if (u > 0) op += dpp<0x4E>(op);
                        d += dpp<0x141>(d); if (u > 0) op += dpp<0x141>(op);
                        d += dpp<0x128>(d); if (u > 0) op += dpp<0x128>(op);
                        if (u > 0) oacc = (js == u - 1) ? op : oacc;
                        S = T + kn * d;
                        op = (S.x * rv.x + S.y * rv.y) + (S.z * rv.z + S.w * rv.w);
                        w = wn; kp = kpn; kk = kkn; kn = knn; rv = rvn; vv = vvn;
                    }
                    op = sum16(op); oacc = (js == 15) ? op : oacc;
                    so[(size_t)(c * TC + 16 * g + js) * AW] = oacc;
                }
#undef SC_LD
                asm volatile("s_waitcnt lgkmcnt(0)" ::: "memory"); lds_st(sw + 16 + 4 * wave, gc + 1u);
            }
            *(f32x4*)(p.out + O_WKVP + ((size_t)(b * 8 + h) * 64 + 16 * qr + irow) * 64 + 4 * js) = S;
        }
    }
}

__device__ __forceinline__ void scan_sample_task(const KP& p, int tk, int lane) {
    const int rg = tk & 3, h = (tk >> 2) & 7, db = tk >> 5;
    const int il = lane >> 2, js = lane & 3, i = 16 * rg + il;
    const float* DEC = (const float*)(p.ws + WS_DEC); const float* KPi = (const float*)(p.ws + WS_KP); const float* KKi = (const float*)(p.ws + WS_KK); const float* KKAi = (const float*)(p.ws + WS_KKA);
    const float* Ri = (const float*)(p.ws + WS_R); const float* VLi = (const float*)(p.ws + WS_VL); float* SO = (float*)(p.ws + WS_SOUT);
    const size_t sbase = (((size_t)db * 8 + h) * 64 + i) * 64 + 16 * js;
    f32x4 S[4];
#pragma unroll
    for (int q = 0; q < 4; ++q) S[q] = *(const f32x4*)(p.in[4] + sbase + 4 * q);
    const int cj = h * HD + 16 * js;
#pragma unroll 1
    for (int t = 0; t < 8; ++t) {
        const size_t m = ((size_t)NP + db * 8 + t) * AW;
        float d = 0.f;
#pragma unroll
        for (int q = 0; q < 4; ++q) { const f32x4 kk = *(const f32x4*)(KKi + m + cj + 4 * q); d += (S[q].x * kk.x + S[q].y * kk.y) + (S[q].z * kk.z + S[q].w * kk.w); }
        d = sum4(d);
        const float vv = VLi[m + h * HD + i];
        float o = 0.f;
#pragma unroll
        for (int q = 0; q < 4; ++q) { const f32x4 w = *(const f32x4*)(DEC + m + cj + 4 * q), kp = *(const f32x4*)(KPi + m + cj + 4 * q), kka = *(const f32x4*)(KKAi + m + cj + 4 * q), rv = *(const f32x4*)(Ri + m + cj + 4 * q);
            S[q] = S[q] * w + kp * vv + kka * d;
            o += (S[q].x * rv.x + S[q].y * rv.y) + (S[q].z * rv.z + S[q].w * rv.w); }
        o = sum4(o);
        if (js == 0) SO[m + h * HD + i] = o;
    }
#pragma unroll
    for (int q = 0; q < 4; ++q) *(f32x4*)(p.out + O_WKVS + sbase + 4 * q) = S[q];
}

template <int NQ, int Q0, int RB> __device__ __forceinline__ void attn_sample_stream(const KP& p, int db, int br, int dil, int cls, int lane) {
    const int h = lane >> 3, c8 = lane & 7, co = h * HD + 8 * c8;
    const bf16* Q = (const bf16*)(p.ws + WS_Q);
    float q[NQ][8], mx[NQ], l[NQ], o[NQ][8];
#pragma unroll
    for (int qi = 0; qi < NQ; ++qi) { const size_t m = (size_t)NP + db * 8 + cls + dil * (Q0 + qi); const v4u w = *(const v4u*)(Q + m * AW + co);
        q[qi][0] = bf2f(w.x & 0xffff); q[qi][1] = bf2f(w.x >> 16); q[qi][2] = bf2f(w.y & 0xffff); q[qi][3] = bf2f(w.y >> 16);
        q[qi][4] = bf2f(w.z & 0xffff); q[qi][5] = bf2f(w.z >> 16); q[qi][6] = bf2f(w.w & 0xffff); q[qi][7] = bf2f(w.w >> 16);
        mx[qi] = -1e30f; l[qi] = 0.f;
#pragma unroll
        for (int e = 0; e < 8; ++e) o[qi][e] = 0.f; }
    const float* CK = p.in[2] + (size_t)db * WBUF * AW + co; const float* CV = p.in[3] + (size_t)db * WBUF * AW + co;
    const int row0 = WBUF - 128 * dil + cls;
#define SBATCH(NR, POS, KA, KB, VA, VB) do { \
        _Pragma("unroll") for (int qi = 0; qi < NQ; ++qi) { float s[NR]; float bm = -1e30f; \
            _Pragma("unroll") for (int u = 0; u < NR; ++u) { \
                float t_ = (q[qi][0] * KA[u].x + q[qi][1] * KA[u].y) + (q[qi][2] * KA[u].z + q[qi][3] * KA[u].w) + (q[qi][4] * KB[u].x + q[qi][5] * KB[u].y) + (q[qi][6] * KB[u].z + q[qi][7] * KB[u].w); \
                t_ = sum8(t_); const bool ok = ((POS) + u >= Q0 + qi) && ((POS) + u <= 128 + Q0 + qi); s[u] = ok ? t_ : -1e30f; bm = fmaxf(bm, s[u]); } \
            const float mn = fmaxf(mx[qi], bm); const float al = __builtin_amdgcn_exp2f(mx[qi] - mn); mx[qi] = mn; float ls = l[qi] * al; \
            _Pragma("unroll") for (int e = 0; e < 8; ++e) o[qi][e] *= al; \
            _Pragma("unroll") for (int u = 0; u < NR; ++u) { const float pe = s[u] > -1e29f ? __builtin_amdgcn_exp2f(s[u] - mn) : 0.f; ls += pe; \
                o[qi][0] += pe * VA[u].x; o[qi][1] += pe * VA[u].y; o[qi][2] += pe * VA[u].z; o[qi][3] += pe * VA[u].w; o[qi][4] += pe * VB[u].x; o[qi][5] += pe * VB[u].y; o[qi][6] += pe * VB[u].z; o[qi][7] += pe * VB[u].w; } \
            l[qi] = ls; } } while (0)
#define SLOAD(POS, KA, KB, VA, VB) do { _Pragma("unroll") for (int u = 0; u < RB; ++u) { const size_t ro = (size_t)(row0 + dil * ((POS) + u)) * AW; \
        KA[u] = __builtin_nontemporal_load((const f32x4*)(CK + ro)); KB[u] = __builtin_nontemporal_load((const f32x4*)(CK + ro + 4)); \
        VA[u] = __builtin_nontemporal_load((const f32x4*)(CV + ro)); VB[u] = __builtin_nontemporal_load((const f32x4*)(CV + ro + 4)); } } while (0)
    f32x4 ka0[RB], kb0[RB], va0[RB], vb0[RB], ka1[RB], kb1[RB], va1[RB], vb1[RB];
    SLOAD(0, ka0, kb0, va0, vb0);
#pragma unroll 1
    for (int pos = 0; pos < 128; pos += 2 * RB) {
        SLOAD(pos + RB, ka1, kb1, va1, vb1);
        SBATCH(RB, pos, ka0, kb0, va0, vb0);
        if (pos + 2 * RB < 128) SLOAD(pos + 2 * RB, ka0, kb0, va0, vb0);
        SBATCH(RB, pos + RB, ka1, kb1, va1, vb1);
    }
    { constexpr int NN = Q0 + NQ, NG = NN > 4 ? 4 : NN;
#pragma unroll
      for (int n0 = 0; n0 < NN; n0 += NG) { f32x4 ka[NG], kb[NG], va[NG], vb_[NG];
#pragma unroll
          for (int n = 0; n < NG; ++n) { const size_t mo = ((size_t)db * 8 + cls + dil * (n0 + n)) * AW + co;
              ka[n] = *(const f32x4*)(p.out + O_KS + mo); kb[n] = *(const f32x4*)(p.out + O_KS + mo + 4); va[n] = *(const f32x4*)(p.out + O_VS + mo); vb_[n] = *(const f32x4*)(p.out + O_VS + mo + 4); }
          SBATCH(NG, 128 + n0, ka, kb, va, vb_); } }
#undef SBATCH
#undef SLOAD
    bf16* AP = (bf16*)(p.ws + WS_APART) + (size_t)br * MT * AW; float* L = (float*)(p.ws + WS_LSE) + (size_t)br * MT * 8;
#pragma unroll
    for (int qi = 0; qi < NQ; ++qi) { const size_t m = (size_t)NP + db * 8 + cls + dil * (Q0 + qi); const float rl = 1.0f / l[qi];
        v4u w; w.x = cvt_pk_bf16(o[qi][0] * rl, o[qi][1] * rl); w.y = cvt_pk_bf16(o[qi][2] * rl, o[qi][3] * rl); w.z = cvt_pk_bf16(o[qi][4] * rl, o[qi][5] * rl); w.w = cvt_pk_bf16(o[qi][6] * rl, o[qi][7] * rl);
        *(v4u*)(AP + m * AW + co) = w;
        if (c8 == 0) L[m * 8 + h] = mx[qi] + __builtin_amdgcn_logf(l[qi]); }
}
#ifndef RB4
#define RB4 2
#endif
#ifndef RB2
#define RB2 2
#endif
#ifndef RB1
#define RB1 4
#endif
constexpr int NTS5 = NDB * 14, NTC5 = NDB * 32;
__device__ __forceinline__ void p5_task(const KP& p, int tk, int lane) {
    if (tk < NTS5) { const int s = tk / NDB, db = tk % NDB;
#ifndef NO_T0
        if (s == 0) attn_sample_stream<4, 0, RB4>(p, db, 0, 1, 0, lane);
#endif
#ifndef NO_T1
        if (s == 1) attn_sample_stream<4, 4, RB4>(p, db, 0, 1, 0, lane);
#endif
#ifndef NO_T2
        if (s >= 2 && s < 6) attn_sample_stream<2, 0, RB2>(p, db, 1, 4, s - 2, lane);
#endif
#ifndef NO_T3
        if (s >= 6) attn_sample_stream<1, 0, RB1>(p, db, 2, 16, s - 6, lane);
#endif
    } else {
#ifndef NO_T4
        scan_sample_task(p, tk - NTS5, lane);
#endif
    }
}

__device__ __forceinline__ void combine_rows(const KP& p, int vcu, int G, int tid) {
    const int wave = __builtin_amdgcn_readfirstlane(tid >> 6), lane = tid & 63, gw = vcu * NWAVES + wave, NGW = G * NWAVES;
    const int h = lane >> 3, c8 = lane & 7, co = h * HD + 8 * c8;
    const bf16* AP = (const bf16*)(p.ws + WS_APART); const float* L = (const float*)(p.ws + WS_LSE);
    const float* VLi = (const float*)(p.ws + WS_VL); const float* SO = (const float*)(p.ws + WS_SOUT); const float* Gi = (const float*)(p.ws + WS_G); const float* BON = (const float*)(p.ws + WS_BON);
    const float* lg = p.in[23]; const float* lb = p.in[24];
    bf16* MIX = (bf16*)(p.ws + WS_MIX);
    const f32x4 g0 = *(const f32x4*)(lg + co), g1 = *(const f32x4*)(lg + co + 4), b0 = *(const f32x4*)(lb + co), b1 = *(const f32x4*)(lb + co + 4);
    for (int m = gw; m < MT; m += NGW) {
        const float l0 = L[(size_t)m * 8 + h], l1 = L[((size_t)MT + m) * 8 + h], l2 = L[((size_t)2 * MT + m) * 8 + h];
        const float lm = fmaxf(l0, fmaxf(l1, l2));
        float w0 = __builtin_amdgcn_exp2f(l0 - lm), w1 = __builtin_amdgcn_exp2f(l1 - lm), w2 = __builtin_amdgcn_exp2f(l2 - lm); const float ws_ = 1.0f / (w0 + w1 + w2); w0 *= ws_; w1 *= ws_; w2 *= ws_;
        const v4u a0 = *(const v4u*)(AP + (size_t)m * AW + co), a1 = *(const v4u*)(AP + ((size_t)MT + m) * AW + co), a2 = *(const v4u*)(AP + ((size_t)2 * MT + m) * AW + co);
        float at[8];
#pragma unroll
        for (int e = 0; e < 4; ++e) { at[2 * e] = w0 * bf2f(a0[e] & 0xffff) + w1 * bf2f(a1[e] & 0xffff) + w2 * bf2f(a2[e] & 0xffff); at[2 * e + 1] = w0 * bf2f(a0[e] >> 16) + w1 * bf2f(a1[e] >> 16) + w2 * bf2f(a2[e] >> 16); }
        v4u wo; wo.x = cvt_pk_bf16(at[0], at[1]); wo.y = cvt_pk_bf16(at[2], at[3]); wo.z = cvt_pk_bf16(at[4], at[5]); wo.w = cvt_pk_bf16(at[6], at[7]);
        *(v4u*)(MIX + (size_t)m * DM + co) = wo;
        const f32x4 o0 = *(const f32x4*)(SO + (size_t)m * AW + co), o1 = *(const f32x4*)(SO + (size_t)m * AW + co + 4);
        const float mean = sum8((o0.x + o0.y) + (o0.z + o0.w) + (o1.x + o1.y) + (o1.z + o1.w)) * (1.0f / 64.0f);
        const f32x4 d0 = o0 - mean, d1 = o1 - mean;
        const float var = sum8((d0.x * d0.x + d0.y * d0.y) + (d0.z * d0.z + d0.w * d0.w) + (d1.x * d1.x + d1.y * d1.y) + (d1.z * d1.z + d1.w * d1.w)) * (1.0f / 64.0f);
        const float rs = 1.0f / sqrtf(var + LNX_EPS);
        const f32x4 v0 = *(const f32x4*)(VLi + (size_t)m * AW + co), v1 = *(const f32x4*)(VLi + (size_t)m * AW + co + 4);
        const float bon = BON[(size_t)m * 8 + h];
        const f32x4 gg0 = *(const f32x4*)(Gi + (size_t)m * AW + co), gg1 = *(const f32x4*)(Gi + (size_t)m * AW + co + 4);
        const f32x4 y0 = (d0 * rs * g0 + b0 + v0 * bon) * gg0, y1 = (d1 * rs * g1 + b1 + v1 * bon) * gg1;
        v4u wr_; wr_.x = cvt_pk_bf16(y0.x, y0.y); wr_.y = cvt_pk_bf16(y0.z, y0.w); wr_.z = cvt_pk_bf16(y1.x, y1.y); wr_.w = cvt_pk_bf16(y1.z, y1.w);
        *(v4u*)(MIX + (size_t)m * DM + AW + co) = wr_;
    }
}

#ifndef REP0
#define REP0 1
#endif
#ifndef REP1
#define REP1 1
#endif
#ifndef REP2
#define REP2 1
#endif
#ifndef REP3
#define REP3 1
#endif
#ifndef REP4
#define REP4 1
#endif
#ifndef REP5
#define REP5 1
#endif
#ifndef REP6
#define REP6 1
#endif
#ifndef REP7
#define REP7 1
#endif
#ifndef REP8
#define REP8 1
#endif
#ifndef REP9
#define REP9 1
#endif
#ifndef REP10
#define REP10 1
#endif
#ifndef REP11
#define REP11 1
#endif
#ifndef REPA
#define REPA 1
#endif
#ifndef REPP
#define REPP 1
#endif
#ifndef TPROBE
#define TPROBE -1
#endif
#ifndef TAMP
#define TAMP 8
#endif
#ifndef PHM
#define PHM 0xFFF
#endif
#define PH(k) if constexpr (((PHM) >> (k)) & 1)
__global__ void __launch_bounds__(NWAVES * 64, 2) hybrid_fwd(KP p) {
    extern __shared__ __attribute__((aligned(16))) unsigned char lds_raw[];
    LAS unsigned char* lds = (LAS unsigned char*)lds_raw;
    volatile LAS unsigned* MISC = (volatile LAS unsigned*)(lds + MISC_OFF);
    const int tid0 = threadIdx.x;
    const int G = gridDim.x; int vcu; { const int bx = blockIdx.x; vcu = (G % 8 == 0) ? (bx % 8) * (G / 8) + bx / 8 : bx; }
    for (int u = tid0; u < (LDS_BYTES - LDSCTL_OFF) / 4; u += NWAVES * 64) ((LAS unsigned*)(lds + LDSCTL_OFF))[u] = 0u;
    __syncthreads();
#if TPROBE >= 0
    unsigned long long tst_[13]; int nst_ = 0; unsigned long long sub_[5] = {0, 0, 0, 0, 0};
    tst_[0] = __builtin_amdgcn_s_memrealtime();
#define SUBSTAMP(i) do { sub_[i] = __builtin_amdgcn_s_memrealtime(); } while (0)
#define TSTAMP() do { tst_[++nst_] = __builtin_amdgcn_s_memrealtime(); } while (0)
#else
#define TSTAMP() do {} while (0)
#define SUBSTAMP(i) do {} while (0)
#endif
    XcdBarrier bar = xcd_barrier_post((unsigned*)(p.ws + WS_CTL) + CW_BAR, MISC + 8);
    const int NGW = G * NWAVES;
    float* mod = (float*)(p.ws + WS_MOD);
#define PHASE_IDS int tid = threadIdx.x; asm volatile("" : "+v"(tid)); const int lane = tid & 63, wave = __builtin_amdgcn_readfirstlane(tid >> 6), gw = vcu * NWAVES + wave; (void)lane; (void)gw;

    _Pragma("unroll") for (int rep_ = 0; rep_ < REP0; ++rep_) { PHASE_IDS
    PH(0) p0_prologue(p, lds, vcu, G, tid);
    xcd_barrier(bar); TSTAMP();
    }
    _Pragma("unroll") for (int rep_ = 0; rep_ < REP1; ++rep_) { PHASE_IDS
    PH(1) { pg8::Gemm g{(const pg8::bf16_t*)(p.ws + WS_SILU), (const pg8::bf16_t*)(p.ws + WS_WADA), 256, MODW, DM}; pg8::StaticOrder S; S.init(256, MODW, G, (int)blockIdx.x);
      pg8::EpiAda E{mod, MODW, p.in[11]};
      pg8::gemm_phase<pg8::EpiAda, pg8::StaticOrder, false, true>(lds + RING_OFF, g, S, E); }
    xcd_barrier(bar); TSTAMP();
    }
    _Pragma("unroll") for (int rep_ = 0; rep_ < REP2; ++rep_) { PHASE_IDS
    PH(2) norm_mod_rows(p.in[0], p.in[1], p.in[8], mod, 0, 1024, (bf16*)(p.ws + WS_H), vcu, G, tid);
    xcd_barrier(bar); TSTAMP();
    }
    _Pragma("unroll") for (int rep_ = 0; rep_ < REP3; ++rep_) { PHASE_IDS
    PH(3) { pg8::Gemm g{(const pg8::bf16_t*)(p.ws + WS_H), (const pg8::bf16_t*)(p.ws + WS_WIN), MT, INW, DM}; pg8::StaticOrder S; S.init(MT, INW, G, (int)blockIdx.x);
      static_assert(WS_K - WS_Q == WS_V - WS_K, "q/k/v buffers equally spaced");
      pg8::EpiProj E{(pg8::bf16_t*)(p.ws + WS_Q), (WS_K - WS_Q) / 2, (float*)(p.ws + WS_P), (const float*)(p.ws + WS_ROPE),
                     p.out, O_KP, O_VP - O_KP, O_KS, O_VS - O_KS, p.out + O_SHP, p.out + O_SHS, QC2};
      pg8::gemm_phase<pg8::EpiProj, pg8::StaticOrder, true, true>(lds + RING_OFF, g, S, E); }
    xcd_barrier(bar); TSTAMP();
    }
    _Pragma("unroll") for (int rep_ = 0; rep_ < REP4; ++rep_) { PHASE_IDS
    PH(4) { LAS unsigned char* wl = lds + RING_OFF + wave * 16384;
      constexpr int NTA = 64 * 192, NTP = NT_PREP;
#define QUEUE_LOOP(QI, NTASK, CALL) do { constexpr int per_ = ((NTASK) + 255) / 256; LAS unsigned* qc_ = (LAS unsigned*)(lds + LDSCTL_OFF + 128 + 4 * (QI)); \
          _Pragma("unroll 1") for (;;) { int li_ = 0; if (lane == 0) li_ = (int)__hip_atomic_fetch_add(qc_, 1u, __ATOMIC_RELAXED, __HIP_MEMORY_SCOPE_WORKGROUP); li_ = __builtin_amdgcn_readfirstlane(li_); \
              const int sl_ = vcu + (li_ / per_) * G; if (sl_ >= 256) break; const int tk = sl_ * per_ + (li_ % per_); if (tk >= (NTASK)) continue; CALL; } } while (0)
      __syncthreads();
      if (tid < 8) ((LAS unsigned*)(lds + LDSCTL_OFF + 128))[tid] = 0u;
      __syncthreads();
      SUBSTAMP(0);
      QUEUE_LOOP(0, 8 * NTG, prep_a_task(p, tk >> 3, tk & 7, wl, lane));
      SUBSTAMP(1);
      QUEUE_LOOP(1, NTA, attn_prompt_task(p, tk, wl, lane));
      SUBSTAMP(2);
      QUEUE_LOOP(2, 4 * NTG, prep_w_task(p, tk >> 2, tk & 3, lane));
      SUBSTAMP(3);
      QUEUE_LOOP(3, 4 * NTG, prep_g_task(p, tk >> 2, tk & 3, lane));
      SUBSTAMP(4);
    }
    xcd_barrier(bar); TSTAMP();
    }
    _Pragma("unroll") for (int rep_ = 0; rep_ < REP5; ++rep_) { PHASE_IDS
    PH(5) {
      const unsigned sw = (unsigned)(uintptr_t)(lds + LDSCTL_OFF);
      __syncthreads();
      if (tid < 40) lds_st(sw + 4 * tid, 0u);
      asm volatile("s_waitcnt lgkmcnt(0)" ::: "memory");
      __syncthreads();
#ifndef NO_SB
      if (wave < 5) scan_block(p, lds + RING_OFF, sw, wave, lane, G, vcu);
#endif
      { LAS unsigned* qc_ = (LAS unsigned*)(lds + LDSCTL_OFF + 128);
        constexpr int PA = (NTS5 + 255) / 256, PS = (NTC5 + 255) / 256;
#pragma unroll 1
        for (;;) { int li = 0; if (lane == 0) li = (int)__hip_atomic_fetch_add(qc_, 1u, __ATOMIC_RELAXED, __HIP_MEMORY_SCOPE_WORKGROUP); li = __builtin_amdgcn_readfirstlane(li);
            const int sl = vcu + (li / (PA + PS)) * G, r = li % (PA + PS); if (sl >= 256) break;
            const int tk = r < PA ? sl * PA + r : NTS5 + sl * PS + (r - PA);
            if (r < PA ? tk < NTS5 : tk < NTS5 + NTC5) p5_task(p, tk, lane); } }
    }
    xcd_barrier(bar); TSTAMP();
    }
    _Pragma("unroll") for (int rep_ = 0; rep_ < REP6; ++rep_) { PHASE_IDS
    PH(6) combine_rows(p, vcu, G, tid);
    xcd_barrier(bar); TSTAMP();
    }
    _Pragma("unroll") for (int rep_ = 0; rep_ < REP7; ++rep_) { PHASE_IDS
    PH(7) { pg8::Gemm g{(const pg8::bf16_t*)(p.ws + WS_MIX), (const pg8::bf16_t*)(p.ws + WS_WOUT), MT, DM, DM}; pg8::StaticOrder S; S.init(MT, DM, G, (int)blockIdx.x);
      pg8::EpiRes E{p.in[0], p.in[1], NP, (float*)(p.ws + WS_X1), DM, mod + 2048, MODW};
      pg8::gemm_phase<pg8::EpiRes, pg8::StaticOrder, true, true>(lds + RING_OFF, g, S, E); }
    xcd_barrier(bar); TSTAMP();
    }
    _Pragma("unroll") for (int rep_ = 0; rep_ < REP8; ++rep_) { PHASE_IDS
    PH(8) norm_mod_rows((const float*)(p.ws + WS_X1), (const float*)(p.ws + WS_X1) + (size_t)NP * DM, p.in[9], mod, 3072, 4096, (bf16*)(p.ws + WS_H), vcu, G, tid);
    xcd_barrier(bar); TSTAMP();
    }
    _Pragma("unroll") for (int rep_ = 0; rep_ < REP9; ++rep_) { PHASE_IDS
    PH(9) { pg8::Gemm g{(const pg8::bf16_t*)(p.ws + WS_H), (const pg8::bf16_t*)(p.ws + WS_WFF1), MT, DFF, DM}; pg8::StaticOrder S; S.init(MT, DFF, G, (int)blockIdx.x);
      pg8::EpiRelu2 E{(pg8::bf16_t*)(p.ws + WS_U), DFF};
      pg8::gemm_phase<pg8::EpiRelu2, pg8::StaticOrder, true, true>(lds + RING_OFF, g, S, E); }
    xcd_barrier(bar); TSTAMP();
    }
    _Pragma("unroll") for (int rep_ = 0; rep_ < REP10; ++rep_) { PHASE_IDS
    PH(10) { pg8::Gemm g{(const pg8::bf16_t*)(p.ws + WS_U), (const pg8::bf16_t*)(p.ws + WS_WFF2), MT, DM, DFF}; pg8::StaticOrder S; S.init(MT, DM, G, (int)blockIdx.x);
      pg8::EpiRes E{(const float*)(p.ws + WS_X1), (const float*)(p.ws + WS_X1) + (size_t)NP * DM, NP, (float*)(p.ws + WS_X2), DM, mod + 5120, MODW};
      pg8::gemm_phase<pg8::EpiRes, pg8::StaticOrder, true, true>(lds + RING_OFF, g, S, E); }
    xcd_barrier(bar); TSTAMP();
    }
    _Pragma("unroll") for (int rep_ = 0; rep_ < REP11; ++rep_) { PHASE_IDS
    PH(11) final_norm_rows((const float*)(p.ws + WS_X2), p.in[27], p.out + O_YP, vcu, G, tid);
    if (rep_ + 1 < REP11) xcd_barrier(bar);
    }
#if TPROBE >= 0
    __syncthreads(); TSTAMP();
    if (blockIdx.x == 0 && threadIdx.x == 0) {
#ifdef TSUB
        const unsigned long long dt = (sub_[TSUB + 1] - sub_[TSUB]) * (unsigned long long)(TAMP);
#else
        const unsigned long long dt = (tst_[TPROBE + 1] - tst_[TPROBE]) * (unsigned long long)(TAMP);
#endif
         const unsigned long long t0 = __builtin_amdgcn_s_memrealtime();
        while (__builtin_amdgcn_s_memrealtime() - t0 < dt) __builtin_amdgcn_s_sleep(8); }
#endif
}

extern "C" void kernel_launch(void* const* d_in, const int* in_sizes, int n_in, void* d_out, int out_size, void* d_ws, size_t ws_size, hipStream_t stream) {
    static int grid = 0;
    if (grid == 0) {
        if (n_in != 28 || (size_t)out_size != O_END || ws_size < WS_END) { fprintf(stderr, "kernel_launch: unexpected shapes (n_in %d out %d ws %zu)\n", n_in, out_size, ws_size); grid = -1; return; }
        int dev = 0, cus = 0, per_cu = 0;
        if (hipGetDevice(&dev) != hipSuccess || hipDeviceGetAttribute(&cus, hipDeviceAttributeMultiprocessorCount, dev) != hipSuccess) { grid = -1; return; }
        if (hipFuncSetAttribute((const void*)hybrid_fwd, hipFuncAttributeMaxDynamicSharedMemorySize, LDS_BYTES) != hipSuccess) { fprintf(stderr, "kernel_launch: hipFuncSetAttribute failed\n"); grid = -1; return; }
        if (hipOccupancyMaxActiveBlocksPerMultiprocessor(&per_cu, (const void*)hybrid_fwd, NWAVES * 64, LDS_BYTES) != hipSuccess || per_cu < 1) fprintf(stderr, "kernel_launch: occupancy query reports %d\n", per_cu);
        (void)hipGetLastError();
        grid = cus;
    }
    if (grid < 0) return;
    if (hipMemsetAsync((char*)d_ws + WS_CTL, 0, CTL_ZERO_BYTES, stream) != hipSuccess) return;
    KP a{};
    for (int i = 0; i < 28; ++i) a.in[i] = (const float*)d_in[i];
    a.out = (float*)d_out; a.ws = (unsigned char*)d_ws;
    hipLaunchKernelGGL(hybrid_fwd, dim3(grid), dim3(NWAVES * 64), LDS_BYTES, stream, a);
}
```

```cpp
#include <hip/hip_runtime.h>
#include <cstdio>
#include <cstdint>
#include <cmath>
namespace pg8 {
#define PG8_LAS __attribute__((address_space(3)))
typedef unsigned short bf16_t;
typedef short bf16x8 __attribute__((ext_vector_type(8)));
typedef float f32x4 __attribute__((ext_vector_type(4)));
typedef unsigned u32x4 __attribute__((ext_vector_type(4)));
constexpr int BM = 256, BK = 64, HALF = 128, HTB = HALF * BK * 2  , STAGE_BYTES = 8 * HTB, NXCD = 8, WGM = 8;

__host__ __device__ __forceinline__ int lds_byte(int r, int c) { const int st = (r >> 4) * 2 + (c >> 5), rr = r & 15, cc = c & 31, ob = rr * 64 + cc * 2; return st * 1024 + (ob ^ (((ob >> 9) & 1) << 5)); }
__host__ __device__ __forceinline__ void stage_rc(int b, int& R, int& C) { const int st = b / 1024, sb = b % 1024, swz = sb ^ (((sb >> 9) & 1) << 5); R = (st >> 1) * 16 + swz / 64; C = (st & 1) * 32 + (swz % 64) / 2; }
__host__ __device__ __forceinline__ int perm32(int rho) { const int n = rho >> 4, i = rho & 15; return 8 * (i >> 2) + 4 * n + (i & 3); }

struct Unit { int pm, pn, kb; };
struct Gemm { const bf16_t* A; const bf16_t* Bt; int M, N, K, ld; };

struct StaticOrder {
    int nM, nN, nwg, G, c;
    __host__ __device__ void init(int M, int N, int G_, int c_) { nM = M / BM; nN = N / BM; nwg = nM * nN; G = G_; c = c_; }
    __host__ __device__ bool next(int i, Unit& u) const {
        const long L = (long)i * G + c; if (L >= nwg) return false;
        int wgid = (int)L; { const int q = nwg / NXCD, r = nwg % NXCD, xcd = wgid % NXCD, off = wgid / NXCD; wgid = (xcd < r ? xcd * (q + 1) : r * (q + 1) + (xcd - r) * q) + off; }
        const int nig = WGM * nN, gid = wgid / nig, fm = gid * WGM, gsz = (nM - fm) < WGM ? (nM - fm) : WGM;
        u.pm = fm + ((wgid % nig) % gsz); u.pn = (wgid % nig) / gsz; u.kb = 0; return true;
    }
    __device__ __forceinline__ void a_ready(const Unit&) const {}
    __device__ __forceinline__ void done(const Unit&) const {}
};

struct SplitOrder {
    int pm0, npm, nN, SK, Kc, G, c;
    __host__ __device__ void init(int pm0_, int npm_, int N, int SK_, int Kc_, int G_, int c_) { pm0 = pm0_; npm = npm_; nN = N / BM; SK = SK_; Kc = Kc_; G = G_; c = c_; }
    __host__ __device__ bool next(int i, Unit& u) const { const long L = (long)i * G + c; if (L >= (long)npm * nN * SK) return false;
        const int l = (int)L, ks = l % SK, r = l / SK; u.pn = r % nN; u.pm = pm0 + r / nN; u.kb = ks * Kc; return true; }
    __device__ __forceinline__ void a_ready(const Unit&) const {}
    __device__ __forceinline__ void done(const Unit&) const {}
};
typedef float f32x2 __attribute__((ext_vector_type(2)));
typedef __bf16 bf16x2_t __attribute__((ext_vector_type(2)));
__device__ __forceinline__ unsigned cvt_pk_bf16(float lo, float hi) { f32x2 v = {lo, hi}; bf16x2_t b = __builtin_convertvector(v, bf16x2_t); return __builtin_bit_cast(unsigned, b); }

constexpr int E_NP = 16384;
__device__ __forceinline__ int e_modrow(int m) { return m < E_NP ? (m >> 11) : 8 + ((m - E_NP) >> 3); }

struct EpiAda {
    static constexpr bool PERM = false, AFTER_DRAIN = false;
    float* out; int ldc; const float* bias;
    __device__ __forceinline__ void operator()(const f32x4 (&acc)[2][2][4][2], const Unit& u, int wr, int wc, int fr, int fq) const {
        const int row0 = u.pm * BM + wr * 64 + fr, col0 = u.pn * BM + wc * 32 + 4 * fq;
#pragma unroll
        for (int ai = 0; ai < 2; ++ai)
#pragma unroll
            for (int m = 0; m < 4; ++m) { float* rowp = out + (size_t)(row0 + ai * HALF + m * 16) * ldc + col0;
#pragma unroll
                for (int bj = 0; bj < 2; ++bj)
#pragma unroll
                    for (int n = 0; n < 2; ++n) { const f32x4 bv = *(const f32x4*)(bias + col0 + bj * HALF + n * 16); *(f32x4*)(rowp + bj * HALF + n * 16) = acc[ai][bj][m][n] + bv; } }
    }
};
struct EpiRes {
    static constexpr bool PERM = false, AFTER_DRAIN = false;
    const float* base0; const float* base1; int split; float* out; int ldc; const float* gate; int gate_ld;
    float* part; int Kc;
    __device__ __forceinline__ void operator()(const f32x4 (&acc)[2][2][4][2], const Unit& u, int wr, int wc, int fr, int fq) const {
        const int row0 = u.pm * BM + wr * 64 + fr, col0 = u.pn * BM + wc * 32 + 4 * fq;
#pragma unroll
        for (int ai = 0; ai < 2; ++ai)
#pragma unroll
            for (int m = 0; m < 4; ++m) { const int row = row0 + ai * HALF + m * 16;
                const float* bp = (row < split ? base0 + (size_t)row * ldc : base1 + (size_t)(row - split) * ldc) + col0;
                const float* gp = gate + (size_t)e_modrow(row) * gate_ld + col0; const int ks = u.kb ? u.kb / Kc : 0;
                float* rowp = ks ? part + ((size_t)(ks - 1) * 1024 + (size_t)(row - split)) * ldc + col0 : out + (size_t)row * ldc + col0;
#pragma unroll
                for (int bj = 0; bj < 2; ++bj)
#pragma unroll
                    for (int n = 0; n < 2; ++n) { const int o = bj * HALF + n * 16; const f32x4 g = *(const f32x4*)(gp + o); f32x4 v = g * acc[ai][bj][m][n]; if (!ks) v = v + *(const f32x4*)(bp + o); *(f32x4*)(rowp + o) = v; } }
    }
};
struct EpiRelu2 {
    static constexpr bool PERM = true, AFTER_DRAIN = false;
    bf16_t* O; int ldc;
    __device__ __forceinline__ void operator()(const f32x4 (&acc)[2][2][4][2], const Unit& u, int wr, int wc, int fr, int fq) const {
        const int row0 = u.pm * BM + wr * 64 + fr, col0 = u.pn * BM + wc * 32 + 8 * fq;
#pragma unroll
        for (int ai = 0; ai < 2; ++ai)
#pragma unroll
            for (int m = 0; m < 4; ++m) { bf16_t* rowp = O + (size_t)(row0 + ai * HALF + m * 16) * ldc + col0;
#pragma unroll
                for (int bj = 0; bj < 2; ++bj) { f32x4 v0 = acc[ai][bj][m][0], v1 = acc[ai][bj][m][1];
                    v0 = __builtin_elementwise_max(v0, (f32x4){0.f, 0.f, 0.f, 0.f}); v1 = __builtin_elementwise_max(v1, (f32x4){0.f, 0.f, 0.f, 0.f}); v0 = v0 * v0; v1 = v1 * v1;
                    u32x4 w; w.x = cvt_pk_bf16(v0[0], v0[1]); w.y = cvt_pk_bf16(v0[2], v0[3]); w.z = cvt_pk_bf16(v1[0], v1[1]); w.w = cvt_pk_bf16(v1[2], v1[3]);
                    *(u32x4*)(rowp + bj * HALF) = w; } }
    }
};
struct EpiProj {
    static constexpr bool PERM = true, AFTER_DRAIN = false;
    bf16_t* QKV; size_t qkv_stride; float* P; const float* rope;
    float* outp; size_t o_kp, o_kv_step_p, o_ks, o_kv_step_s; float *shift_p, *shift_s; float c2;
    __device__ __forceinline__ void operator()(const f32x4 (&acc)[2][2][4][2], const Unit& u, int wr, int wc, int fr, int fq) const {
        const int row0 = u.pm * BM + wr * 64 + fr, pn = u.pn;
        const int lcol = wc * 32 + 8 * fq;
        if (pn < 6) {
            const int kind = pn >> 1;
            const int c0 = (pn & 1) * 256 + lcol;
            const bool dorope = (kind < 2) && ((wc & 1) == 0);
#pragma unroll
            for (int ai = 0; ai < 2; ++ai)
#pragma unroll
                for (int m = 0; m < 4; ++m) { const int row = row0 + ai * HALF + m * 16;
                    f32x4 cs0 = {1.f, 1.f, 1.f, 1.f}, cs1 = cs0, sn0 = {0.f, 0.f, 0.f, 0.f}, sn1 = sn0;
                    if (dorope) { const int ridx = row < E_NP ? (row & 2047) : 2048 + ((row - E_NP) & 7); const float* rp = rope + (size_t)ridx * 16;
                        cs0 = *(const f32x4*)(rp); cs1 = *(const f32x4*)(rp + 4); sn0 = *(const f32x4*)(rp + 8); sn1 = *(const f32x4*)(rp + 12); }
#pragma unroll
                    for (int bj = 0; bj < 2; ++bj) { f32x4 v0 = acc[ai][bj][m][0], v1 = acc[ai][bj][m][1];
                        if (dorope) {
                            f32x4 p0, p1;
#pragma unroll
                            for (int e = 0; e < 4; ++e) { p0[e] = __shfl_xor(v0[e], 16); p1[e] = __shfl_xor(v1[e], 16); }
                            if (fq == 0) { v0 = v0 * cs0 - p0 * sn0; v1 = v1 * cs1 - p1 * sn1; }
                            else if (fq == 1) { v0 = p0 * sn0 + v0 * cs0; v1 = p1 * sn1 + v1 * cs1; }
                        }
                        const int c = c0 + bj * HALF;
                        if (kind >= 1) { float* fo = outp + (row < E_NP ? o_kp + (size_t)(kind - 1) * o_kv_step_p + (size_t)row * 512 : o_ks + (size_t)(kind - 1) * o_kv_step_s + (size_t)(row - E_NP) * 512);
                            *(f32x4*)(fo + c) = v0; *(f32x4*)(fo + c + 4) = v1; }
                        if (kind == 0) { v0 = v0 * c2; v1 = v1 * c2; }
                        u32x4 w; w.x = cvt_pk_bf16(v0[0], v0[1]); w.y = cvt_pk_bf16(v0[2], v0[3]); w.z = cvt_pk_bf16(v1[0], v1[1]); w.w = cvt_pk_bf16(v1[2], v1[3]);
                        bf16_t* bo = QKV + (size_t)kind * qkv_stride + (size_t)row * 512 + c;
                        *(u32x4*)bo = w; } }
        } else {
            const int c0 = (pn - 6) * 256 + lcol;
#pragma unroll
            for (int ai = 0; ai < 2; ++ai)
#pragma unroll
                for (int m = 0; m < 4; ++m) { const int row = row0 + ai * HALF + m * 16; float* po = P + (size_t)row * 1792 + c0;
                    float* so = nullptr;
                    if (row < E_NP) { if ((row & 2047) == 2047) so = shift_p + (size_t)(row >> 11) * 1792 + c0; }
                    else { const int ms = row - E_NP; if ((ms & 7) == 7) so = shift_s + (size_t)(ms >> 3) * 1792 + c0; }
#pragma unroll
                    for (int bj = 0; bj < 2; ++bj) { const f32x4 v0 = acc[ai][bj][m][0], v1 = acc[ai][bj][m][1];
                        *(f32x4*)(po + bj * HALF) = v0; *(f32x4*)(po + bj * HALF + 4) = v1;
                        if (so) { *(f32x4*)(so + bj * HALF) = v0; *(f32x4*)(so + bj * HALF + 4) = v1; } } }
        }
    }
};

template <class Epi, class Sched, bool ALIGN_EPI = false, bool SP2 = false>
__device__ __forceinline__ void gemm_phase(PG8_LAS unsigned char* lds, const Gemm g, const Sched& S, const Epi& E) {
    int tid_ = threadIdx.x; asm volatile("" : "+v"(tid_));
    const int tid = tid_, wid = __builtin_amdgcn_readfirstlane(tid >> 6), lane = tid & 63, wr = wid >> 2, wc = wid & 3, fr = lane & 15, fq = lane >> 4;
    const int K = g.ld, nt = g.K / BK;
    unsigned voffA[2], voffB[2];
#pragma unroll
    for (int i = 0; i < 2; ++i) { int R, C; stage_rc(tid * 16 + i * 8192, R, C); const int Rb = Epi::PERM ? ((R & ~31) + perm32(R & 31)) : R;
        voffA[i] = (unsigned)(R * K + C) * 2u; voffB[i] = (unsigned)(Rb * K + C) * 2u; }
    const size_t kstep = (size_t)(BK * 2);
    const size_t hstep = (size_t)HALF * K * 2;
    const size_t tstep = 2 * hstep;
    const unsigned ldsw = (unsigned)wid * 1024u;
    const int aoff = lds_byte(wr * 64 + fr, fq * 8), boff = lds_byte(wc * 32 + fr, fq * 8);
#define PG8_SA(b, h) (((b) * 2 + (h)) * HTB)
#define PG8_SB(b, h) ((4 + (b) * 2 + (h)) * HTB)
#define PG8_STAGE(bufoff, gbase, voff) do { _Pragma("unroll") for (int _i = 0; _i < 2; ++_i) \
        __builtin_amdgcn_global_load_lds((const unsigned*)((const char*)(gbase) + (voff)[_i]), (PG8_LAS unsigned*)(lds + (bufoff) + ldsw + _i * 8192), 16, 0, 0); } while (0)
#define PG8_LDA(dst, b, h) do { _Pragma("unroll") for (int m = 0; m < 4; ++m) _Pragma("unroll") for (int k = 0; k < 2; ++k) dst[m][k] = *(const PG8_LAS bf16x8*)(lds + PG8_SA(b, h) + aoff + m * 2048 + k * 1024); } while (0)
#define PG8_LDB(dst, b, h) do { _Pragma("unroll") for (int n = 0; n < 2; ++n) _Pragma("unroll") for (int k = 0; k < 2; ++k) dst[n][k] = *(const PG8_LAS bf16x8*)(lds + PG8_SB(b, h) + boff + n * 2048 + k * 1024); } while (0)
#define PG8_MMA(ai, bj, At, Bt) do { __builtin_amdgcn_s_setprio(1); _Pragma("unroll") for (int m = 0; m < 4; ++m) _Pragma("unroll") for (int n = 0; n < 2; ++n) _Pragma("unroll") for (int k = 0; k < 2; ++k) \
        acc[ai][bj][m][n] = __builtin_amdgcn_mfma_f32_16x16x32_bf16(Bt[n][k], At[m][k], acc[ai][bj][m][n], 0, 0, 0); __builtin_amdgcn_s_setprio(0); } while (0)
#define PG8_WAIT_V(n) asm volatile("s_waitcnt vmcnt(" #n ")" ::: "memory")
#define PG8_WAIT_L(n) asm volatile("s_waitcnt lgkmcnt(" #n ")" ::: "memory")
#define PG8_BAR __builtin_amdgcn_s_barrier()
#define PG8_SCHED __builtin_amdgcn_sched_barrier(0)
    Unit cur, nxt; int ui = 0;
    if (!S.next(0, cur)) return;
    f32x4 acc[2][2][4][2];
#pragma unroll
    for (int a = 0; a < 2; ++a)
#pragma unroll
        for (int b = 0; b < 2; ++b)
#pragma unroll
            for (int m = 0; m < 4; ++m)
#pragma unroll
                for (int n = 0; n < 2; ++n) acc[a][b][m][n] = (f32x4){0.f, 0.f, 0.f, 0.f};
    bf16x8 At[4][2], B0[2][2], B1[2][2];
    const char* cA = (const char*)g.A + (size_t)cur.pm * tstep + (size_t)cur.kb * 2; const char* cB = (const char*)g.Bt + (size_t)cur.pn * tstep + (size_t)cur.kb * 2;
    S.a_ready(cur);
    if constexpr (SP2) {
        PG8_STAGE(PG8_SB(0, 0), cB, voffB); PG8_STAGE(PG8_SB(0, 1), cB + hstep, voffB); PG8_STAGE(PG8_SA(0, 0), cA, voffA); PG8_STAGE(PG8_SA(0, 1), cA + hstep, voffA);
        if (wr == 1) PG8_BAR;
        PG8_WAIT_V(2); PG8_BAR;
        PG8_STAGE(PG8_SB(1, 0), cB + kstep, voffB); PG8_STAGE(PG8_SA(1, 0), cA + kstep, voffA); PG8_STAGE(PG8_SB(1, 1), cB + hstep + kstep, voffB);
        PG8_WAIT_V(6); PG8_BAR;
    } else {
        PG8_STAGE(PG8_SB(0, 0), cB, voffB); PG8_STAGE(PG8_SA(0, 0), cA, voffA); PG8_STAGE(PG8_SB(0, 1), cB + hstep, voffB); PG8_STAGE(PG8_SA(0, 1), cA + hstep, voffA);
        if (wr == 1) PG8_BAR;
        PG8_WAIT_V(4); PG8_BAR;
        PG8_STAGE(PG8_SB(1, 0), cB + kstep, voffB); PG8_STAGE(PG8_SA(1, 0), cA + kstep, voffA); PG8_STAGE(PG8_SB(1, 1), cB + hstep + kstep, voffB);
        PG8_WAIT_V(6); PG8_BAR;
    }
    for (;;) {
        const bool has_next = S.next(ui + 1, nxt);
        const char* nA = has_next ? (const char*)g.A + (size_t)nxt.pm * tstep + (size_t)nxt.kb * 2 : cA; const char* nB = has_next ? (const char*)g.Bt + (size_t)nxt.pn * tstep + (size_t)nxt.kb * 2 : cB;
        for (int t = 0; t < nt; t += 2) {
            const bool last = (t == nt - 2);
            const char* a1 = cA + (size_t)(t + 1) * kstep;
            const char* a2 = last ? nA : cA + (size_t)(t + 2) * kstep; const char* b2 = last ? nB : cB + (size_t)(t + 2) * kstep;
            const char* a3 = a2 + kstep; const char* b3 = b2 + kstep;
            if (last && has_next) S.a_ready(nxt);
            if constexpr (SP2) {
            PG8_LDB(B0, 0, 0); PG8_LDB(B1, 0, 1); PG8_SCHED; PG8_LDA(At, 0, 0); PG8_STAGE(PG8_SA(1, 1), a1 + hstep, voffA);
            PG8_WAIT_V(8); PG8_WAIT_L(0); PG8_BAR; PG8_MMA(0, 0, At, B0); PG8_MMA(0, 1, At, B1); PG8_BAR; PG8_SCHED;
            PG8_LDA(At, 0, 1); PG8_STAGE(PG8_SB(0, 0), b2, voffB); PG8_STAGE(PG8_SB(0, 1), b2 + hstep, voffB); PG8_STAGE(PG8_SA(0, 0), a2, voffA);
            PG8_WAIT_V(8); PG8_WAIT_L(0); PG8_BAR; PG8_MMA(1, 0, At, B0); PG8_MMA(1, 1, At, B1); PG8_BAR; PG8_SCHED;
            PG8_LDB(B0, 1, 0); PG8_LDB(B1, 1, 1); PG8_SCHED; PG8_LDA(At, 1, 0); PG8_STAGE(PG8_SA(0, 1), a2 + hstep, voffA);
            PG8_WAIT_V(8); PG8_WAIT_L(0); PG8_BAR; PG8_MMA(0, 0, At, B0); PG8_MMA(0, 1, At, B1); PG8_BAR; PG8_SCHED;
            PG8_LDA(At, 1, 1); PG8_STAGE(PG8_SB(1, 0), b3, voffB); PG8_STAGE(PG8_SB(1, 1), b3 + hstep, voffB); PG8_STAGE(PG8_SA(1, 0), a3, voffA);
            PG8_WAIT_V(8); PG8_WAIT_L(0); PG8_BAR; PG8_MMA(1, 0, At, B0); PG8_MMA(1, 1, At, B1); PG8_BAR; PG8_SCHED;
            } else {
            PG8_LDB(B0, 0, 0); PG8_SCHED; PG8_LDA(At, 0, 0); PG8_STAGE(PG8_SA(1, 1), a1 + hstep, voffA);
            PG8_WAIT_L(8); PG8_BAR; PG8_WAIT_L(0); PG8_MMA(0, 0, At, B0); PG8_BAR; PG8_SCHED;
            PG8_LDB(B1, 0, 1); PG8_STAGE(PG8_SB(0, 0), b2, voffB);
            PG8_BAR; PG8_WAIT_L(0); PG8_MMA(0, 1, At, B1); PG8_BAR;
            PG8_LDA(At, 0, 1); PG8_STAGE(PG8_SA(0, 0), a2, voffA);
            PG8_BAR; PG8_WAIT_L(0); PG8_MMA(1, 0, At, B0); PG8_BAR; PG8_SCHED;
            PG8_STAGE(PG8_SB(0, 1), b2 + hstep, voffB);
            PG8_WAIT_V(6); PG8_BAR; PG8_MMA(1, 1, At, B1); PG8_BAR;
            PG8_LDB(B0, 1, 0); PG8_SCHED; PG8_LDA(At, 1, 0); PG8_STAGE(PG8_SA(0, 1), a2 + hstep, voffA);
            PG8_WAIT_L(8); PG8_BAR; PG8_WAIT_L(0); PG8_MMA(0, 0, At, B0); PG8_BAR; PG8_SCHED;
            PG8_LDB(B1, 1, 1); PG8_STAGE(PG8_SB(1, 0), b3, voffB);
            PG8_BAR; PG8_WAIT_L(0); PG8_MMA(0, 1, At, B1); PG8_BAR;
            PG8_LDA(At, 1, 1); PG8_STAGE(PG8_SA(1, 0), a3, voffA);
            PG8_BAR; PG8_WAIT_L(0); PG8_MMA(1, 0, At, B0); PG8_BAR; PG8_SCHED;
            PG8_STAGE(PG8_SB(1, 1), b3 + hstep, voffB);
            PG8_WAIT_V(6); PG8_BAR; PG8_MMA(1, 1, At, B1); PG8_BAR;
            }
        }
        if constexpr (ALIGN_EPI) { if (wr == 0) PG8_BAR; }
        if constexpr (!Epi::AFTER_DRAIN) { E(acc, cur, wr, wc, fr, fq); S.done(cur); }
        if (!has_next) break;
#pragma unroll
        for (int a = 0; a < 2; ++a)
#pragma unroll
            for (int b = 0; b < 2; ++b)
#pragma unroll
                for (int m = 0; m < 4; ++m)
#pragma unroll
                    for (int n = 0; n < 2; ++n) acc[a][b][m][n] = (f32x4){0.f, 0.f, 0.f, 0.f};
        cur = nxt; cA = nA; cB = nB; ++ui;
        if constexpr (ALIGN_EPI) { if (wr == 1) PG8_BAR; }
    }
    PG8_WAIT_V(0);
    if constexpr (!ALIGN_EPI) { if (wr == 0) PG8_BAR; }
    PG8_BAR;
    if constexpr (Epi::AFTER_DRAIN) { E.fused(acc, cur, wr, wc, fr, fq, lds, wid, lane); S.done(cur); }
#undef PG8_SA
#undef PG8_SB
#undef PG8_STAGE
#undef PG8_LDA
#undef PG8_LDB
#undef PG8_MMA
#undef PG8_WAIT_V
#undef PG8_WAIT_L
#undef PG8_BAR
#undef PG8_SCHED
}
}

#define GAS __attribute__((address_space(1)))
#define LAS __attribute__((address_space(3)))
typedef unsigned short bf16;
typedef unsigned v4u __attribute__((ext_vector_type(4)));
typedef float f32x4 __attribute__((ext_vector_type(4)));
typedef short bf16x8 __attribute__((ext_vector_type(8)));
typedef GAS unsigned gu32;
typedef GAS unsigned long long gu64;
#define RLX_AGENT __ATOMIC_RELAXED, __HIP_MEMORY_SCOPE_AGENT
#define LDS_WAIT() asm volatile("s_waitcnt lgkmcnt(0)" ::: "memory")
#define VM_WAIT() asm volatile("s_waitcnt vmcnt(0)" ::: "memory")
__device__ __forceinline__ unsigned long long rt() { return __builtin_amdgcn_s_memrealtime(); }
__device__ __forceinline__ unsigned f2bf(float f) { unsigned u = __builtin_bit_cast(unsigned, f); return (u + 0x7fffu + ((u >> 16) & 1u)) >> 16; }
__device__ __forceinline__ unsigned pk2(float lo, float hi) { return f2bf(lo) | (f2bf(hi) << 16); }
#define XB_TMO      128
#define XB_XCNT(j)  (256  + 64 * (j))
#define XB_XSUB(j)  (1280 + 64 * (j))
#define XB_XGEN(j)  (2304 + 64 * (j))
#define XB_TOP      3328
#define XB_TOPGEN   3392
#define XCD_BAR_WORDS 3456
#define XB_SPIN_CAP (1u << 18)

__device__ __forceinline__ unsigned xb_ld(unsigned* p)              { return __hip_atomic_load(p, __ATOMIC_RELAXED, __HIP_MEMORY_SCOPE_AGENT); }
__device__ __forceinline__ unsigned xb_add(unsigned* p, unsigned v) { return __hip_atomic_fetch_add(p, v, __ATOMIC_RELAXED, __HIP_MEMORY_SCOPE_AGENT); }
__device__ __forceinline__ unsigned xb_xcc_id() { return (unsigned)__builtin_amdgcn_s_getreg((3 << 11) | 20) & 0xFu; }
#define XB_SPIN(cond, bar) do { unsigned _sp = 0; while (cond) { __builtin_amdgcn_s_sleep(1); \
    if ((++_sp & 255u) == 0u) { if (xb_ld(&(bar)[XB_TMO])) break; if (_sp > XB_SPIN_CAP) { atomicAdd(&(bar)[XB_TMO], 1u); break; } } } } while (0)

struct XcdBarrier {
    unsigned* bar; unsigned x;
    volatile LAS unsigned* st;
};

__device__ __forceinline__ XcdBarrier xcd_barrier_post(unsigned* bar, volatile LAS unsigned* st) {
    XcdBarrier b; b.bar = bar; b.x = xb_xcc_id(); b.st = st;
    if (threadIdx.x == 0) (void)xb_add(&bar[XB_XCNT(b.x)], 1u);
    return b;
}
__device__ __forceinline__ void xcd_barrier_complete(unsigned* bar, unsigned x, unsigned& nloc, unsigned& nx) {
    const unsigned G = gridDim.x * gridDim.y * gridDim.z;
    unsigned sum, cnt, mine, sp = 0u;
    for (;;) {
        sum = 0u; cnt = 0u; mine = 0u;
#pragma unroll
        for (unsigned j = 0; j < 16; ++j) { const unsigned c = xb_ld(&bar[XB_XCNT(j)]); sum += c; cnt += (c > 0u) ? 1u : 0u; mine = (j == x) ? c : mine; }
        if (sum == G) break;
        __builtin_amdgcn_s_sleep(1);
        if ((++sp & 255u) == 0u) { if (xb_ld(&bar[XB_TMO])) break; if (sp > XB_SPIN_CAP) { atomicAdd(&bar[XB_TMO], 1u); break; } }
    }
    nloc = mine > 0u ? mine : 1u; nx = cnt > 0u ? cnt : 1u;
}

__device__ __forceinline__ void xcd_barrier(const XcdBarrier& b) {
    asm volatile("s_waitcnt vmcnt(0)" ::: "memory");
    __syncthreads();
    if (threadIdx.x == 0) {
        unsigned* bar = b.bar;
        __builtin_amdgcn_s_waitcnt(0);
        unsigned nloc = b.st[0], nx = b.st[1];
        if (nloc == 0u) { xcd_barrier_complete(bar, b.x, nloc, nx); b.st[0] = nloc; b.st[1] = nx; }
        const unsigned old = xb_add(&bar[XB_XSUB(b.x)], 1u);
        const unsigned gen = old / nloc;
        if (old + 1u == (gen + 1u) * nloc) {
            __builtin_amdgcn_fence(__ATOMIC_RELEASE, "agent");
            asm volatile("s_waitcnt vmcnt(0)" ::: "memory");
            const unsigned og = xb_add(&bar[XB_TOP], 1u);
            const unsigned tg = og / nx;
            if (og + 1u == (tg + 1u) * nx) xb_add(&bar[XB_TOPGEN], 1u);
            else XB_SPIN(xb_ld(&bar[XB_TOPGEN]) == tg, bar);
            __builtin_amdgcn_fence(__ATOMIC_ACQUIRE, "agent");
            xb_add(&bar[XB_XGEN(b.x)], 1u);
            asm volatile("s_waitcnt vmcnt(0)" ::: "memory");
        } else {
            XB_SPIN(xb_ld(&bar[XB_XGEN(b.x)]) == gen, bar);
            __builtin_amdgcn_fence(__ATOMIC_ACQUIRE, "agent");
            asm volatile("s_waitcnt vmcnt(0)" ::: "memory");
        }
    }
    __syncthreads();
}

__device__ __forceinline__ float wave_sum(float v) {
#pragma unroll
    for (int o = 1; o < 64; o <<= 1) v += __shfl_xor(v, o);
    return v;
}
__device__ __forceinline__ void p0_transpose_item(const float* W, int K, int N, bf16* WT, int row_off, LAS float* scr, int item, int lane) {
    const int nblk = N / 32, kb = item / nblk, nb = item % nblk, k0 = 64 * kb, n0 = 32 * nb;
#pragma unroll 8
    for (int i = 0; i < 32; ++i) { const int kk = 2 * i + (lane >> 5); scr[kk * 33 + (lane & 31)] = W[(size_t)(k0 + kk) * N + n0 + (lane & 31)]; }
    LDS_WAIT(); asm volatile("" ::: "memory");
    const int c = lane & 7;
#pragma unroll
    for (int j = 0; j < 4; ++j) { const int n = (lane >> 3) + 8 * j; const LAS float* s = scr + (8 * c) * 33 + n;
        v4u o; o.x = pk2(s[0 * 33], s[1 * 33]); o.y = pk2(s[2 * 33], s[3 * 33]); o.z = pk2(s[4 * 33], s[5 * 33]); o.w = pk2(s[6 * 33], s[7 * 33]);
        *(GAS v4u*)(WT + (size_t)(row_off + n0 + n) * K + k0 + 8 * c) = o; }
    LDS_WAIT(); asm volatile("" ::: "memory");
}

constexpr int DM = 1024, NP = 16384, NSM = 1024, MT = NP + NSM;
constexpr int SEQ = 2048, NDB = 128, WBUF = 2048;
constexpr int INW = 3328, RIN = 1792, AW = 512, DFF = 4096, HD = 64;
constexpr int MODW = 6144;
constexpr float NORM_EPS = 1e-6f, LNX_EPS = 64e-5f;
constexpr float QC2 = 0.125f * 1.4426950408889634f;
constexpr int NWAVES = 8;

constexpr size_t MiB = 1u << 20;
constexpr size_t WS_CTL = 0, CTL_ZERO_BYTES = 1 * MiB;
constexpr size_t WS_WIN = 2 * MiB, WS_WOUT = 9 * MiB, WS_WFF1 = 11 * MiB, WS_WFF2 = 19 * MiB, WS_WADA = 27 * MiB;
constexpr size_t WS_SILU = 39 * MiB, WS_ROPE = 40 * MiB, WS_LW2 = 41 * MiB, WS_LA2 = 41 * MiB + 65536, WS_LG2 = 41 * MiB + 131072;
constexpr size_t WS_MOD = 42 * MiB, WS_H = 48 * MiB, WS_Q = 82 * MiB, WS_K = 99 * MiB, WS_V = 116 * MiB, WS_P = 133 * MiB;
constexpr size_t WS_DEC = 252 * MiB, WS_KP = 286 * MiB, WS_KK = 320 * MiB, WS_KKA = 354 * MiB, WS_G = 388 * MiB, WS_BON = 422 * MiB;
constexpr size_t WS_SOUT = 423 * MiB, WS_APART = 457 * MiB, WS_LSE = 508 * MiB, WS_MIX = 510 * MiB, WS_X1 = 544 * MiB, WS_U = 612 * MiB, WS_X2 = 748 * MiB, WS_R = 816 * MiB, WS_VL = 850 * MiB, WS_PART = 884 * MiB, WS_END = 916 * MiB;
constexpr int SK_OUT = 4, SK_FF2 = 8;
constexpr int CW_BAR = 4096, CW_Q5 = 64, CW_Q4 = 1024;
constexpr size_t ZROW_OFF = 524288;
constexpr size_t O_YP = 0, O_YS = 16777216, O_KP = 17825792, O_VP = 26214400, O_WKVP = 34603008, O_SHP = 34865152, O_KS = 34879488, O_VS = 35403776, O_WKVS = 35928064, O_SHS = 40122368, O_END = 40351744;

constexpr int RING_OFF = 0, RING_BYTES = 131072;
constexpr int LDSCTL_OFF = RING_BYTES, MISC_OFF = LDSCTL_OFF + 320;
constexpr int LDS_BYTES = 147456;

struct KP { const float* in[28]; float* out; unsigned char* ws; };

typedef float f32x16 __attribute__((ext_vector_type(16)));
typedef float f32x2 __attribute__((ext_vector_type(2)));
typedef short s16x4 __attribute__((ext_vector_type(4)));
#define NEG_INF (-__builtin_inff())
#define MFMA32(a, b, c) __builtin_amdgcn_mfma_f32_32x32x16_bf16((a), (b), (c), 0, 0, 0)
__device__ __forceinline__ int crow(int r, int hi) { return (r & 3) + 8 * (r >> 2) + 4 * hi; }
using pg8::cvt_pk_bf16;
__device__ __forceinline__ bf16x8 pack8(float a0, float a1, float a2, float a3, float a4, float a5, float a6, float a7) {
    v4u w; w.x = cvt_pk_bf16(a0, a1); w.y = cvt_pk_bf16(a2, a3); w.z = cvt_pk_bf16(a4, a5); w.w = cvt_pk_bf16(a6, a7); return __builtin_bit_cast(bf16x8, w); }
__device__ __forceinline__ float bf2f(unsigned short b) { return __builtin_bit_cast(float, (unsigned)b << 16); }
template <int CTRL> __device__ __forceinline__ float dpp(float x) { return __builtin_bit_cast(float, __builtin_amdgcn_mov_dpp(__builtin_bit_cast(int, x), CTRL, 0xf, 0xf, true)); }
__device__ __forceinline__ float sum4(float x) { x += dpp<0xB1>(x); x += dpp<0x4E>(x); return x; }
__device__ __forceinline__ float sum8(float x) { x = sum4(x); x += dpp<0x141>(x); return x; }
__device__ __forceinline__ float sum16(float x) { x = sum8(x); x += dpp<0x128>(x); return x; }
__device__ __forceinline__ float sum32(float x) { x = sum16(x); x += __shfl_xor(x, 16); return x; }
__device__ __forceinline__ float fexp_(float x) { return __builtin_amdgcn_exp2f(x * 1.4426950408889634f); }
__device__ __forceinline__ float sigmoidf_(float x) { return __builtin_amdgcn_rcpf(1.0f + fexp_(-x)); }
__device__ __forceinline__ float tanhf_(float x) { return 1.0f - 2.0f * __builtin_amdgcn_rcpf(1.0f + fexp_(2.0f * x)); }
__device__ __forceinline__ int modrow(int m) { return m < NP ? (m >> 11) : 8 + ((m - NP) >> 3); }

__device__ __forceinline__ void p0_prologue(const KP& p, LAS unsigned char* lds, int vcu, int G, int tid) {
    const int wave = __builtin_amdgcn_readfirstlane(tid >> 6), lane = tid & 63;
    LAS float* scr = (LAS float*)(lds + RING_OFF + wave * 16384);
    const int gw = vcu * NWAVES + wave, NGW = G * NWAVES;
    constexpr int I_IN = (DM / 64) * (INW / 32), I_OUT = (DM / 64) * (DM / 32), I_F1 = (DM / 64) * (DFF / 32), I_F2 = (DFF / 64) * (DM / 32), I_ADA = (DM / 64) * (MODW / 32);
    constexpr int NITEMS = I_IN + I_OUT + I_F1 + I_F2 + I_ADA;
    for (int it = gw; it < NITEMS; it += NGW) {
        int r = it;
        if (r < I_IN) { p0_transpose_item(p.in[12], DM, INW, (bf16*)(p.ws + WS_WIN), 0, scr, r, lane); continue; } r -= I_IN;
        if (r < I_OUT) { p0_transpose_item(p.in[13], DM, DM, (bf16*)(p.ws + WS_WOUT), 0, scr, r, lane); continue; } r -= I_OUT;
        if (r < I_F1) { p0_transpose_item(p.in[25], DM, DFF, (bf16*)(p.ws + WS_WFF1), 0, scr, r, lane); continue; } r -= I_F1;
        if (r < I_F2) { p0_transpose_item(p.in[26], DFF, DM, (bf16*)(p.ws + WS_WFF2), 0, scr, r, lane); continue; } r -= I_F2;
        p0_transpose_item(p.in[10], DM, MODW, (bf16*)(p.ws + WS_WADA), 0, scr, r, lane);
    }
    const int gt = vcu * (NWAVES * 64) + tid, NGT = G * NWAVES * 64;
    for (int g = gt; g < 256 * 256; g += NGT) { const int row = g >> 8, c4 = (g & 255) * 4;
        f32x4 c = {0.f, 0.f, 0.f, 0.f};
        if (row < 8) c = *(const f32x4*)(p.in[6] + (size_t)row * DM + c4); else if (row < 136) c = *(const f32x4*)(p.in[7] + (size_t)(row - 8) * DM + c4);
        f32x4 s; for (int e = 0; e < 4; ++e) s[e] = c[e] / (1.0f + expf(-c[e]));
        unsigned long long o = (unsigned long long)cvt_pk_bf16(s[0], s[1]) | ((unsigned long long)cvt_pk_bf16(s[2], s[3]) << 32);
        *(unsigned long long*)((bf16*)(p.ws + WS_SILU) + (size_t)row * DM + c4) = o; }
    for (int e = gt; e < 2056 * 8; e += NGT) { const int idx = e >> 3, i = e & 7; const int pos = idx < 2048 ? idx : 8192 + (idx - 2048);
        const double inv = exp(-(double)i * (0.125 * 13.122363377404328));
        const double ang = (double)pos * inv; const double k = rint(ang * 0.15915494309189535); const float rr = (float)(ang - k * 6.283185307179586);
        float* t = (float*)(p.ws + WS_ROPE) + (size_t)idx * 16; t[i] = cosf(rr); t[8 + i] = sinf(rr); }
    for (int e = gt; e < 16384; e += NGT) {
        const float* W; bf16x8* dst; int KS, r = e;
        if (r < 4096) { W = p.in[16]; dst = (bf16x8*)(p.ws + WS_LW2); KS = 4; } else if (r < 8192) { r -= 4096; W = p.in[18]; dst = (bf16x8*)(p.ws + WS_LA2); KS = 4; } else { r -= 8192; W = p.in[19]; dst = (bf16x8*)(p.ws + WS_LG2); KS = 8; }
        const int ln = r & 63, fk = r >> 6, nt = fk / KS, ks = fk % KS; const int n = 32 * nt + (ln & 31), k0 = 16 * ks + 8 * (ln >> 5);
        float w[8]; for (int j = 0; j < 8; ++j) w[j] = W[(size_t)(k0 + j) * 512 + n];
        dst[r] = pack8(w[0], w[1], w[2], w[3], w[4], w[5], w[6], w[7]); }
}

__device__ __forceinline__ void norm_mod_rows(const float* x0, const float* x1, const float* gain, const float* mod, int sh_off, int sc_off, bf16* H, int vcu, int G, int tid, const float* part = nullptr, int nslab = 0, float* xsum = nullptr) {
    const int wave = __builtin_amdgcn_readfirstlane(tid >> 6), lane = tid & 63, gw = vcu * NWAVES + wave, NGW = G * NWAVES;
    for (int m = gw; m < MT; m += NGW) {
        const float* xr = m < NP ? x0 + (size_t)m * DM : x1 + (size_t)(m - NP) * DM;
        const GAS f32x4* xv = (const GAS f32x4*)xr + lane;
        f32x4 v[4]; float s = 0.f;
#pragma unroll
        for (int j = 0; j < 4; ++j) v[j] = xv[64 * j];
        if (nslab && m >= NP) {
            for (int k = 0; k < nslab; ++k) { const GAS f32x4* pv = (const GAS f32x4*)(part + ((size_t)k * 1024 + (m - NP)) * DM) + lane;
#pragma unroll
                for (int j = 0; j < 4; ++j) v[j] = v[j] + pv[64 * j]; }
            GAS f32x4* xo = (GAS f32x4*)(xsum + (size_t)(m - NP) * DM) + lane;
#pragma unroll
            for (int j = 0; j < 4; ++j) xo[64 * j] = v[j]; }
#pragma unroll
        for (int j = 0; j < 4; ++j) s += (v[j].x * v[j].x + v[j].y * v[j].y) + (v[j].z * v[j].z + v[j].w * v[j].w);
        const float rstd = 1.0f / sqrtf(wave_sum(s) * (1.0f / DM) + NORM_EPS);
        const float* mr = mod + (size_t)modrow(m) * MODW;
        GAS unsigned long long* o8 = (GAS unsigned long long*)(H + (size_t)m * DM) + lane;
#pragma unroll
        for (int j = 0; j < 4; ++j) { const int c = 4 * lane + 256 * j;
            const f32x4 g = *(const f32x4*)(gain + c), sc = *(const f32x4*)(mr + sc_off + c), sh = *(const f32x4*)(mr + sh_off + c);
            const f32x4 o = v[j] * rstd * g * (sc + 1.0f) + sh;
            o8[64 * j] = (unsigned long long)cvt_pk_bf16(o.x, o.y) | ((unsigned long long)cvt_pk_bf16(o.z, o.w) << 32); }
    }
}
__device__ __forceinline__ void final_norm_rows(const float* X, const float* gain, float* out, int vcu, int G, int tid, const float* part, int nslab) {
    const int wave = __builtin_amdgcn_readfirstlane(tid >> 6), lane = tid & 63, gw = vcu * NWAVES + wave, NGW = G * NWAVES;
    for (int m = gw; m < MT; m += NGW) {
        const GAS f32x4* xv = (const GAS f32x4*)(X + (size_t)m * DM) + lane;
        f32x4 v[4]; float s = 0.f;
#pragma unroll
        for (int j = 0; j < 4; ++j) v[j] = xv[64 * j];
        if (m >= NP) for (int k = 0; k < nslab; ++k) { const GAS f32x4* pv = (const GAS f32x4*)(part + ((size_t)k * 1024 + (m - NP)) * DM) + lane;
#pragma unroll
            for (int j = 0; j < 4; ++j) v[j] = v[j] + pv[64 * j]; }
#pragma unroll
        for (int j = 0; j < 4; ++j) s += (v[j].x * v[j].x + v[j].y * v[j].y) + (v[j].z * v[j].z + v[j].w * v[j].w);
        const float rstd = 1.0f / sqrtf(wave_sum(s) * (1.0f / DM) + NORM_EPS);
        GAS f32x4* ov = (GAS f32x4*)(out + (size_t)m * DM) + lane;
#pragma unroll
        for (int j = 0; j < 4; ++j) { const f32x4 g = *(const f32x4*)(gain + 4 * lane + 256 * j); ov[64 * j] = v[j] * rstd * g; }
    }
}

constexpr int VP = 144;
constexpr int WLDS = 32 * VP + 256;
#define TRR(dst, off) asm volatile("ds_read_b64_tr_b16 %0, %1 offset:%c2" : "=&v"(dst) : "v"(vb), "i"(off) : "memory")
__device__ __forceinline__ void attn_prompt_task(const KP& p, int tk, LAS unsigned char* wl, int lane) {
    const bf16* Q = (const bf16*)(p.ws + WS_Q); const bf16* K = (const bf16*)(p.ws + WS_K); const bf16* V = (const bf16*)(p.ws + WS_V);
    const int bh = tk / 192, rem = tk % 192, unit = rem >> 2, qt = rem & 3, b = bh >> 3, h = bh & 7;
    int br, dil, cls, nb;
    if (unit < 16) { br = 0; dil = 1; cls = 0; nb = unit; } else if (unit < 32) { br = 1; dil = 4; cls = (unit - 16) & 3; nb = (unit - 16) >> 2; } else { br = 2; dil = 16; cls = unit - 32; nb = 0; }
    const int r32 = lane & 31, hi = lane >> 5, m0 = nb * 128 + qt * 32;
    const size_t rowb = (size_t)b * SEQ;
    const int pq = (m0 + r32) * dil + cls;
    bf16x8 qr[4];
    { const bf16* qp = Q + (rowb + pq) * AW + h * HD + hi * 8;
#pragma unroll
      for (int d0 = 0; d0 < 4; ++d0) qr[d0] = *(const bf16x8*)(qp + d0 * 16); }
    const int kt_lo = (nb == 0) ? 4 - qt : 0;
    bf16x8 kf[5][4];
#pragma unroll
    for (int kt = 0; kt < 5; ++kt) {
        const int kidx = m0 - 128 + 32 * kt + r32; const int pk = (kidx < 0 ? 0 : kidx) * dil + cls;
        const bf16* kp = K + (rowb + pk) * AW + h * HD + hi * 8;
#pragma unroll
        for (int d0 = 0; d0 < 4; ++d0) kf[kt][d0] = *(const bf16x8*)(kp + d0 * 16);
    }
    f32x16 S[5];
#pragma unroll
    for (int kt = 0; kt < 5; ++kt) {
        f32x16 a;
#pragma unroll
        for (int r = 0; r < 16; ++r) a[r] = 0.f;
#pragma unroll
        for (int d0 = 0; d0 < 4; ++d0) a = MFMA32(kf[kt][d0], qr[d0], a);
        if (kt < kt_lo) {
#pragma unroll
            for (int r = 0; r < 16; ++r) a[r] = NEG_INF;
        }
        if (kt == 0) {
#pragma unroll
            for (int r = 0; r < 16; ++r) if (crow(r, hi) < r32) a[r] = NEG_INF;
        }
        if (kt == 4) {
#pragma unroll
            for (int r = 0; r < 16; ++r) if (crow(r, hi) > r32) a[r] = NEG_INF;
        }
        S[kt] = a;
    }
    v4u vv[5][4];
#pragma unroll
    for (int kt = 0; kt < 5; ++kt)
#pragma unroll
        for (int i = 0; i < 4; ++i) { const int rr = (lane >> 3) + 8 * i, ch = lane & 7; const int kidx = m0 - 128 + 32 * kt + rr; const int pk = (kidx < 0 ? 0 : kidx) * dil + cls;
            vv[kt][i] = *(const v4u*)(V + (rowb + pk) * AW + h * HD + ch * 8); }
    float mx = NEG_INF;
#pragma unroll
    for (int kt = 0; kt < 5; ++kt)
#pragma unroll
        for (int r = 0; r < 16; ++r) mx = fmaxf(mx, S[kt][r]);
    mx = fmaxf(mx, __shfl_xor(mx, 32));
    float l = 0.f;
#pragma unroll
    for (int kt = 0; kt < 5; ++kt)
#pragma unroll
        for (int r = 0; r < 16; ++r) { const float e = __builtin_amdgcn_exp2f(S[kt][r] - mx); S[kt][r] = e; l += e; }
    l += __shfl_xor(l, 32);
    f32x16 o0, o1;
#pragma unroll
    for (int r = 0; r < 16; ++r) { o0[r] = 0.f; o1[r] = 0.f; }
    const int i16 = lane & 15, q4 = i16 >> 2, p4 = i16 & 3, g16 = (lane >> 4) & 1;
    const unsigned vb = (unsigned)(uintptr_t)wl + (unsigned)((4 * hi + q4) * VP + 32 * g16 + 8 * p4);
#pragma unroll
    for (int kt = 0; kt < 5; ++kt) {
        if (kt >= kt_lo) {
#pragma unroll
            for (int i = 0; i < 4; ++i) { const int rr = (lane >> 3) + 8 * i, ch = lane & 7; *(LAS v4u*)(wl + rr * VP + ch * 16) = vv[kt][i]; }
            const bf16x8 pa0 = pack8(S[kt][0], S[kt][1], S[kt][2], S[kt][3], S[kt][4], S[kt][5], S[kt][6], S[kt][7]);
            const bf16x8 pa1 = pack8(S[kt][8], S[kt][9], S[kt][10], S[kt][11], S[kt][12], S[kt][13], S[kt][14], S[kt][15]);
            s16x4 t00l, t00h, t01l, t01h, t10l, t10h, t11l, t11h;
            asm volatile("s_waitcnt lgkmcnt(0)" ::: "memory");
            TRR(t00l, 0);                 TRR(t00h, 8 * VP);
            TRR(t01l, 64);                TRR(t01h, 8 * VP + 64);
            TRR(t10l, 16 * VP);           TRR(t10h, 24 * VP);
            TRR(t11l, 16 * VP + 64);      TRR(t11h, 24 * VP + 64);
            asm volatile("s_waitcnt lgkmcnt(0)" ::: "memory");
            __builtin_amdgcn_sched_barrier(0);
#define PKV(lo, hi_) (bf16x8){lo[0], lo[1], lo[2], lo[3], hi_[0], hi_[1], hi_[2], hi_[3]}
            o0 = MFMA32(pa0, PKV(t00l, t00h), o0); o1 = MFMA32(pa0, PKV(t01l, t01h), o1);
            o0 = MFMA32(pa1, PKV(t10l, t10h), o0); o1 = MFMA32(pa1, PKV(t11l, t11h), o1);
#undef PKV
        }
    }
    LAS float* ls = (LAS float*)(wl + 32 * VP);
    if (hi == 0) ls[r32] = l;
    asm volatile("s_waitcnt lgkmcnt(0)" ::: "memory");
    float rl[16];
#pragma unroll
    for (int r = 0; r < 16; ++r) rl[r] = 1.0f / ls[crow(r, hi)];
    LAS unsigned short* stg = (LAS unsigned short*)wl;
#pragma unroll
    for (int r = 0; r < 16; ++r) { const int orow = crow(r, hi);
        stg[orow * 64 + r32] = (unsigned short)(cvt_pk_bf16(o0[r] * rl[r], 0.f) & 0xffffu);
        stg[orow * 64 + 32 + r32] = (unsigned short)(cvt_pk_bf16(o1[r] * rl[r], 0.f) & 0xffffu); }
    asm volatile("s_waitcnt lgkmcnt(0)" ::: "memory");
    bf16* AP = (bf16*)(p.ws + WS_APART) + (size_t)br * MT * AW;
#pragma unroll
    for (int i = 0; i < 4; ++i) { const int row = i * 8 + (lane >> 3), ch = lane & 7; const v4u v = *(const LAS v4u*)(stg + row * 64 + ch * 8);
        const int pr = (m0 + row) * dil + cls; *(v4u*)(AP + (rowb + pr) * AW + h * HD + ch * 8) = v; }
    if (hi == 0) { float* L = (float*)(p.ws + WS_LSE) + (size_t)br * MT * 8; L[(rowb + pq) * 8 + h] = mx + __builtin_amdgcn_logf(l); }
    asm volatile("s_waitcnt lgkmcnt(0)" ::: "memory");
}

template <int ACT> __device__ __forceinline__ bf16x8 prep_afrag(const float* pr, const float* pp, const float* mu, int c) {
    float x[8];
#pragma unroll
    for (int q = 0; q < 2; ++q) { const f32x4 a = *(const f32x4*)(pr + c + 4 * q), bq = *(const f32x4*)(pp + c + 4 * q), mq = *(const f32x4*)(mu + c + 4 * q); const f32x4 y = a + (bq - a) * mq;
        x[4 * q] = y.x; x[4 * q + 1] = y.y; x[4 * q + 2] = y.z; x[4 * q + 3] = y.w; }
    if (ACT == 1) {
#pragma unroll
        for (int j = 0; j < 8; ++j) x[j] = tanhf_(x[j]); }
    if (ACT == 2) {
#pragma unroll
        for (int j = 0; j < 8; ++j) x[j] = sigmoidf_(x[j]); }
    return pack8(x[0], x[1], x[2], x[3], x[4], x[5], x[6], x[7]);
}
__device__ __forceinline__ const float* prev_row(const KP& p, const float* P, int m) {
    if (m < NP) return (m & 2047) == 0 ? (const float*)(p.ws + WS_CTL + ZROW_OFF) : P + (size_t)(m - 1) * RIN;
    const int ms = m - NP; return (ms & 7) == 0 ? p.in[5] + (size_t)(ms >> 3) * RIN : P + (size_t)(m - 1) * RIN;
}
constexpr int LA_PITCH = 272;
__device__ __forceinline__ void prep_a_task(const KP& p, int tg, int hh, LAS unsigned char* wl, int lane) {
    const int r32 = lane & 31, hi = lane >> 5;
    const float* P = (const float*)(p.ws + WS_P); const float* mu = p.in[14];
    bf16x8 aa[4];
    { const int m = 32 * tg + r32; const float* pr = P + (size_t)m * RIN; const float* pp = prev_row(p, P, m);
#pragma unroll
      for (int ks = 0; ks < 4; ++ks) aa[ks] = prep_afrag<0>(pr, pp, mu, 1600 + 16 * ks + 8 * hi); }
    const bf16x8* LA2 = (const bf16x8*)(p.ws + WS_LA2);
    float* KPo = (float*)(p.ws + WS_KP); float* KKo = (float*)(p.ws + WS_KK); float* KKAo = (float*)(p.ws + WS_KKA); float* BON = (float*)(p.ws + WS_BON); float* Ro = (float*)(p.ws + WS_R); float* VLo = (float*)(p.ws + WS_VL);
    f32x16 d0, d1;
#pragma unroll
    for (int r = 0; r < 16; ++r) { d0[r] = 0.f; d1[r] = 0.f; }
#pragma unroll
    for (int ks = 0; ks < 4; ++ks) { d0 = MFMA32(aa[ks], LA2[((2 * hh) * 4 + ks) * 64 + lane], d0); d1 = MFMA32(aa[ks], LA2[((2 * hh + 1) * 4 + ks) * 64 + lane], d1); }
#pragma unroll
    for (int r = 0; r < 16; ++r) { LAS float* row = (LAS float*)(wl + crow(r, hi) * LA_PITCH); row[r32] = d0[r]; row[32 + r32] = d1[r]; }
    asm volatile("s_waitcnt lgkmcnt(0)" ::: "memory");
    const int tq = lane >> 4, ch4 = lane & 15, c = 64 * hh + 4 * ch4;
    const f32x4 muk = *(const f32x4*)(mu + 512 + c), mur = *(const f32x4*)(mu + c), muv = *(const f32x4*)(mu + 1024 + c);
    const f32x4 a0q = *(const f32x4*)(p.in[17] + c), kkq = *(const f32x4*)(p.in[20] + c), kaq = *(const f32x4*)(p.in[21] + c), rkq = *(const f32x4*)(p.in[22] + c);
#pragma unroll 4
    for (int it = 0; it < 8; ++it) { const int t = 4 * it + tq, m = 32 * tg + t;
        const float* pr = P + (size_t)m * RIN + c; const float* pp = prev_row(p, P, m) + c;
        const f32x4 kx = *(const f32x4*)(pr + 512), ky = *(const f32x4*)(pp + 512), rx = *(const f32x4*)(pr), ry = *(const f32x4*)(pp), vx = *(const f32x4*)(pr + 1024), vy = *(const f32x4*)(pp + 1024);
        const f32x4 aL = *(const LAS f32x4*)(wl + t * LA_PITCH + ch4 * 16);
        const f32x4 kl = kx + (ky - kx) * muk, rl = rx + (ry - rx) * mur, vl = vx + (vy - vx) * muv, kr = kl * kkq;
        const float n2 = sum16((kr.x * kr.x + kr.y * kr.y) + (kr.z * kr.z + kr.w * kr.w));
        const float rn = 1.0f / fmaxf(sqrtf(n2), 1e-12f);
        f32x4 av; av.x = sigmoidf_(a0q.x + aL.x); av.y = sigmoidf_(a0q.y + aL.y); av.z = sigmoidf_(a0q.z + aL.z); av.w = sigmoidf_(a0q.w + aL.w);
        const f32x4 kp = kl * ((av - 1.0f) * kaq + 1.0f), kn = kr * rn, bq = rl * kp * rkq;
        const float bn = sum16((bq.x + bq.y) + (bq.z + bq.w));
        const size_t ob = (size_t)m * AW + c;
        *(f32x4*)(KPo + ob) = kp; *(f32x4*)(KKo + ob) = kn; *(f32x4*)(KKAo + ob) = -(kn * av);
        *(f32x4*)(Ro + ob) = rl; *(f32x4*)(VLo + ob) = vl;
        if (ch4 == 0) BON[(size_t)m * 8 + hh] = bn; }
    asm volatile("s_waitcnt lgkmcnt(0)" ::: "memory");
}
__device__ __forceinline__ void prep_w_task(const KP& p, int tg, int hp, int lane) {
    const int r32 = lane & 31, hi = lane >> 5;
    const float* P = (const float*)(p.ws + WS_P); const float* mu = p.in[14];
    bf16x8 aw[4];
    { const int m = 32 * tg + r32; const float* pr = P + (size_t)m * RIN; const float* pp = prev_row(p, P, m);
#pragma unroll
      for (int ks = 0; ks < 4; ++ks) aw[ks] = prep_afrag<1>(pr, pp, mu, 1536 + 16 * ks + 8 * hi); }
    const bf16x8* LW2 = (const bf16x8*)(p.ws + WS_LW2); float* DEC = (float*)(p.ws + WS_DEC); const float* w0 = p.in[15];
#pragma unroll 1
    for (int nt = 4 * hp; nt < 4 * hp + 4; ++nt) { const int c = 32 * nt + r32;
        f32x16 d;
#pragma unroll
        for (int r = 0; r < 16; ++r) d[r] = 0.f;
#pragma unroll
        for (int ks = 0; ks < 4; ++ks) d = MFMA32(aw[ks], LW2[(nt * 4 + ks) * 64 + lane], d);
        const float w0c = w0[c];
#pragma unroll
        for (int r = 0; r < 16; ++r) DEC[(size_t)(32 * tg + crow(r, hi)) * AW + c] = fexp_(-0.6065306597126334f * sigmoidf_(w0c + d[r])); }
}
__device__ __forceinline__ void prep_g_task(const KP& p, int tg, int hp, int lane) {
    const int r32 = lane & 31, hi = lane >> 5;
    const float* P = (const float*)(p.ws + WS_P); const float* mu = p.in[14];
    bf16x8 ag[8];
    { const int m = 32 * tg + r32; const float* pr = P + (size_t)m * RIN; const float* pp = prev_row(p, P, m);
#pragma unroll
      for (int ks = 0; ks < 8; ++ks) ag[ks] = prep_afrag<2>(pr, pp, mu, 1664 + 16 * ks + 8 * hi); }
    const bf16x8* LG2 = (const bf16x8*)(p.ws + WS_LG2); float* Go = (float*)(p.ws + WS_G);
#pragma unroll 1
    for (int nt = 4 * hp; nt < 4 * hp + 4; ++nt) { const int c = 32 * nt + r32;
        f32x16 d;
#pragma unroll
        for (int r = 0; r < 16; ++r) d[r] = 0.f;
#pragma unroll
        for (int ks = 0; ks < 8; ++ks) d = MFMA32(ag[ks], LG2[(nt * 8 + ks) * 64 + lane], d);
#pragma unroll
        for (int r = 0; r < 16; ++r) Go[(size_t)(32 * tg + crow(r, hi)) * AW + c] = d[r]; }
}
constexpr int NTG = MT / 32, NT_PREP = 10 * NTG;

constexpr int TC = 32, SC_ARR = TC * 64 * 4, SCB = 5 * SC_ARR + TC * 16 * 4, NBUF = 3, NCH = SEQ / TC;
static_assert(NBUF * SCB <= RING_BYTES, "scan ring fits the LDS ring region");
__device__ __forceinline__ unsigned lds_ld(unsigned addr) { unsigned v; asm volatile("ds_read_b32 %0, %1\n\ts_waitcnt lgkmcnt(0)" : "=v"(v) : "v"(addr) : "memory"); return v; }
__device__ __forceinline__ void lds_st(unsigned addr, unsigned v) { asm volatile("ds_write_b32 %0, %1" :: "v"(addr), "v"(v) : "memory"); }
__device__ __forceinline__ void scan_block(const KP& p, LAS unsigned char* lds, unsigned sw, int wave, int lane, int G, int vcu) {
    const float* DEC = (const float*)(p.ws + WS_DEC); const float* KPi = (const float*)(p.ws + WS_KP); const float* KKi = (const float*)(p.ws + WS_KK); const float* KKAi = (const float*)(p.ws + WS_KKA);
    const float* Ri = (const float*)(p.ws + WS_R); const float* VLi = (const float*)(p.ws + WS_VL); float* SO = (float*)(p.ws + WS_SOUT);
    unsigned gc = 0;
#pragma unroll 1
    for (int item = vcu; item < 256; item += G) {
        const int b = item >> 5, h = (item >> 2) & 7, qr = item & 3; const size_t rowb = (size_t)b * SEQ;
        if (wave == 4) {
            const size_t la = (size_t)(lane >> 4) * AW + h * HD + 4 * (lane & 15), lv = (size_t)(lane >> 2) * AW + h * HD + 16 * qr + 4 * (lane & 3);
#pragma unroll 1
            for (int c = 0; c < NCH; ++c, ++gc) {
                if (gc >= (unsigned)NBUF) { const unsigned need = gc - NBUF + 1; unsigned sp = 0;
                    for (;;) { const unsigned d0 = lds_ld(sw + 16), d1 = lds_ld(sw + 20), d2 = lds_ld(sw + 24), d3 = lds_ld(sw + 28);
                        const unsigned mn = min(min(d0, d1), min(d2, d3)); if (mn >= need) break;
                        __builtin_amdgcn_s_sleep(2); if (++sp > (1u << 22)) { lds_st(sw + 64, 1u); break; } } }
                LAS unsigned char* buf = lds + (gc % NBUF) * SCB; const size_t m0 = (rowb + (size_t)c * TC) * AW;
#pragma unroll
                for (int i = 0; i < 8; ++i) { const size_t o = m0 + (size_t)(4 * i) * AW + la;
                    __builtin_amdgcn_global_load_lds((const unsigned*)(DEC + o), (LAS unsigned*)(buf + 0 * SC_ARR + i * 1024), 16, 0, 0);
                    __builtin_amdgcn_global_load_lds((const unsigned*)(KPi + o), (LAS unsigned*)(buf + 1 * SC_ARR + i * 1024), 16, 0, 0);
                    __builtin_amdgcn_global_load_lds((const unsigned*)(KKi + o), (LAS unsigned*)(buf + 2 * SC_ARR + i * 1024), 16, 0, 0);
                    __builtin_amdgcn_global_load_lds((const unsigned*)(KKAi + o), (LAS unsigned*)(buf + 3 * SC_ARR + i * 1024), 16, 0, 0);
                    __builtin_amdgcn_global_load_lds((const unsigned*)(Ri + o), (LAS unsigned*)(buf + 4 * SC_ARR + i * 1024), 16, 0, 0); }
#pragma unroll
                for (int i = 0; i < 2; ++i) __builtin_amdgcn_global_load_lds((const unsigned*)(VLi + m0 + (size_t)(16 * i) * AW + lv), (LAS unsigned*)(buf + 5 * SC_ARR + i * 1024), 16, 0, 0);
                if (c >= 1) { asm volatile("s_waitcnt vmcnt(42)" ::: "memory"); lds_st(sw, gc); }
            }
            asm volatile("s_waitcnt vmcnt(0)" ::: "memory"); lds_st(sw, gc);
        } else {
            __builtin_amdgcn_s_setprio(3);
            const int il = lane >> 4, js = lane & 15, irow = 4 * wave + il;
            f32x4 S = {0.f, 0.f, 0.f, 0.f};
            float* so = SO + rowb * AW + h * HD + 16 * qr + irow;
#pragma unroll 1
            for (int c = 0; c < NCH; ++c, ++gc) {
                { unsigned sp = 0; while (lds_ld(sw) < gc + 1u) { __builtin_amdgcn_s_sleep(1); if (++sp > (1u << 22)) { lds_st(sw + 64, 1u); break; } } }
                const LAS unsigned char* buf = lds + (gc % NBUF) * SCB + js * 16; const LAS unsigned char* vbuf = lds + (gc % NBUF) * SCB + 5 * SC_ARR + irow * 4;
#define SC_LD(T_, W, KP_, KK_, KN_, RV_, VV_) do { const LAS unsigned char* b_ = buf + (T_) * 256; W = *(const LAS f32x4*)(b_); KP_ = *(const LAS f32x4*)(b_ + SC_ARR); KK_ = *(const LAS f32x4*)(b_ + 2 * SC_ARR); \
        KN_ = *(const LAS f32x4*)(b_ + 3 * SC_ARR); RV_ = *(const LAS f32x4*)(b_ + 4 * SC_ARR); VV_ = *(const LAS float*)(vbuf + (T_) * 64); } while (0)
                f32x4 Wv[3], KPv[3], KKv[3], KNv[3], RVv[3]; float VVv[3];
                SC_LD(0, Wv[0], KPv[0], KKv[0], KNv[0], RVv[0], VVv[0]);
                SC_LD(1, Wv[1], KPv[1], KKv[1], KNv[1], RVv[1], VVv[1]);
#pragma unroll
                for (int g = 0; g < TC / 16; ++g) {
                    float oacc = 0.f, op = 0.f;
#pragma unroll
                    for (int u = 0; u < 16; ++u) { const int t = 16 * g + u, cu = t % 3, n2 = (t + 2) % 3;
                        if (t + 2 < TC) { SC_LD(t + 2, Wv[n2], KPv[n2], KKv[n2], KNv[n2], RVv[n2], VVv[n2]); __builtin_amdgcn_sched_barrier(0); }
                        const f32x4 w = Wv[cu], kp = KPv[cu], kk = KKv[cu], kn = KNv[cu], rv = RVv[cu]; const float vv = VVv[cu];
                        float d = (S.x * kk.x + S.y * kk.y) + (S.z * kk.z + S.w * kk.w);
                        const f32x4 T = S * w + kp * vv;
                        d += dpp<0xB1>(d); if (u > 0) op += dpp<0xB1>(op);
                        d += dpp<0x4E>(d); if (u > 0) op += dpp<0x4E>(op);
                        d += dpp<0x141>(d); if (u > 0) op += dpp<0x141>(op);
                        d += dpp<0x128>(d); if (u > 0) op += dpp<0x128>(op);
                        if (u > 0) oacc = (js == u - 1) ? op : oacc;
                        S = T + kn * d;
                        op = (S.x * rv.x + S.y * rv.y) + (S.z * rv.z + S.w * rv.w);
                    }
                    op = sum16(op); oacc = (js == 15) ? op : oacc;
                    so[(size_t)(c * TC + 16 * g + js) * AW] = oacc;
                }
#undef SC_LD
                asm volatile("s_waitcnt lgkmcnt(0)" ::: "memory"); lds_st(sw + 16 + 4 * wave, gc + 1u);
            }
            *(f32x4*)(p.out + O_WKVP + ((size_t)(b * 8 + h) * 64 + 16 * qr + irow) * 64 + 4 * js) = S;
            __builtin_amdgcn_s_setprio(0);
        }
    }
}

__device__ __forceinline__ void scan_sample_task(const KP& p, int tk, int lane) {
    const int rg = tk & 3, h = (tk >> 2) & 7, db = tk >> 5;
    const int il = lane >> 2, js = lane & 3, i = 16 * rg + il;
    const float* DEC = (const float*)(p.ws + WS_DEC); const float* KPi = (const float*)(p.ws + WS_KP); const float* KKi = (const float*)(p.ws + WS_KK); const float* KKAi = (const float*)(p.ws + WS_KKA);
    const float* Ri = (const float*)(p.ws + WS_R); const float* VLi = (const float*)(p.ws + WS_VL); float* SO = (float*)(p.ws + WS_SOUT);
    const size_t sbase = (((size_t)db * 8 + h) * 64 + i) * 64 + 16 * js;
    f32x4 S[4];
#pragma unroll
    for (int q = 0; q < 4; ++q) S[q] = *(const f32x4*)(p.in[4] + sbase + 4 * q);
    const int cj = h * HD + 16 * js;
#pragma unroll 1
    for (int t = 0; t < 8; ++t) {
        const size_t m = ((size_t)NP + db * 8 + t) * AW;
        float d = 0.f;
#pragma unroll
        for (int q = 0; q < 4; ++q) { const f32x4 kk = *(const f32x4*)(KKi + m + cj + 4 * q); d += (S[q].x * kk.x + S[q].y * kk.y) + (S[q].z * kk.z + S[q].w * kk.w); }
        d = sum4(d);
        const float vv = VLi[m + h * HD + i];
        float o = 0.f;
#pragma unroll
        for (int q = 0; q < 4; ++q) { const f32x4 w = *(const f32x4*)(DEC + m + cj + 4 * q), kp = *(const f32x4*)(KPi + m + cj + 4 * q), kka = *(const f32x4*)(KKAi + m + cj + 4 * q), rv = *(const f32x4*)(Ri + m + cj + 4 * q);
            S[q] = S[q] * w + kp * vv + kka * d;
            o += (S[q].x * rv.x + S[q].y * rv.y) + (S[q].z * rv.z + S[q].w * rv.w); }
        o = sum4(o);
        if (js == 0) SO[m + h * HD + i] = o;
    }
#pragma unroll
    for (int q = 0; q < 4; ++q) *(f32x4*)(p.out + O_WKVS + sbase + 4 * q) = S[q];
}

template <int NQ, int Q0, int RB> __device__ __forceinline__ void attn_sample_stream(const KP& p, int db, int br, int dil, int cls, int lane) {
    const int h = lane >> 3, c8 = lane & 7, co = h * HD + 8 * c8;
    const bf16* Q = (const bf16*)(p.ws + WS_Q);
    float q[NQ][8], mx[NQ], l[NQ], o[NQ][8];
#pragma unroll
    for (int qi = 0; qi < NQ; ++qi) { const size_t m = (size_t)NP + db * 8 + cls + dil * (Q0 + qi); const v4u w = *(const v4u*)(Q + m * AW + co);
        q[qi][0] = bf2f(w.x & 0xffff); q[qi][1] = bf2f(w.x >> 16); q[qi][2] = bf2f(w.y & 0xffff); q[qi][3] = bf2f(w.y >> 16);
        q[qi][4] = bf2f(w.z & 0xffff); q[qi][5] = bf2f(w.z >> 16); q[qi][6] = bf2f(w.w & 0xffff); q[qi][7] = bf2f(w.w >> 16);
        mx[qi] = -1e30f; l[qi] = 0.f;
#pragma unroll
        for (int e = 0; e < 8; ++e) o[qi][e] = 0.f; }
    const float* CK = p.in[2] + (size_t)db * WBUF * AW + co; const float* CV = p.in[3] + (size_t)db * WBUF * AW + co;
    const int row0 = WBUF - 128 * dil + cls;
#define SBATCH(NR, POS, KA, KB, VA, VB) do { \
        _Pragma("unroll") for (int qi = 0; qi < NQ; ++qi) { float s[NR]; float bm = -1e30f; \
            _Pragma("unroll") for (int u = 0; u < NR; ++u) { \
                float t_ = (q[qi][0] * KA[u].x + q[qi][1] * KA[u].y) + (q[qi][2] * KA[u].z + q[qi][3] * KA[u].w) + (q[qi][4] * KB[u].x + q[qi][5] * KB[u].y) + (q[qi][6] * KB[u].z + q[qi][7] * KB[u].w); \
                t_ = sum8(t_); const bool ok = ((POS) + u >= Q0 + qi) && ((POS) + u <= 128 + Q0 + qi); s[u] = ok ? t_ : -1e30f; bm = fmaxf(bm, s[u]); } \
            const float mn = fmaxf(mx[qi], bm); const float al = __builtin_amdgcn_exp2f(mx[qi] - mn); mx[qi] = mn; float ls = l[qi] * al; \
            _Pragma("unroll") for (int e = 0; e < 8; ++e) o[qi][e] *= al; \
            _Pragma("unroll") for (int u = 0; u < NR; ++u) { const float pe = s[u] > -1e29f ? __builtin_amdgcn_exp2f(s[u] - mn) : 0.f; ls += pe; \
                o[qi][0] += pe * VA[u].x; o[qi][1] += pe * VA[u].y; o[qi][2] += pe * VA[u].z; o[qi][3] += pe * VA[u].w; o[qi][4] += pe * VB[u].x; o[qi][5] += pe * VB[u].y; o[qi][6] += pe * VB[u].z; o[qi][7] += pe * VB[u].w; } \
            l[qi] = ls; } } while (0)
#define SLOAD(POS, KA, KB, VA, VB) do { _Pragma("unroll") for (int u = 0; u < RB; ++u) { const size_t ro = (size_t)(row0 + dil * ((POS) + u)) * AW; \
        KA[u] = __builtin_nontemporal_load((const f32x4*)(CK + ro)); KB[u] = __builtin_nontemporal_load((const f32x4*)(CK + ro + 4)); \
        VA[u] = __builtin_nontemporal_load((const f32x4*)(CV + ro)); VB[u] = __builtin_nontemporal_load((const f32x4*)(CV + ro + 4)); } } while (0)
    f32x4 ka0[RB], kb0[RB], va0[RB], vb0[RB], ka1[RB], kb1[RB], va1[RB], vb1[RB];
    SLOAD(0, ka0, kb0, va0, vb0);
#pragma unroll 1
    for (int pos = 0; pos < 128; pos += 2 * RB) {
        SLOAD(pos + RB, ka1, kb1, va1, vb1);
        SBATCH(RB, pos, ka0, kb0, va0, vb0);
        if (pos + 2 * RB < 128) SLOAD(pos + 2 * RB, ka0, kb0, va0, vb0);
        SBATCH(RB, pos + RB, ka1, kb1, va1, vb1);
    }
    { constexpr int NN = Q0 + NQ, NG = NN > 4 ? 4 : NN;
#pragma unroll
      for (int n0 = 0; n0 < NN; n0 += NG) { f32x4 ka[NG], kb[NG], va[NG], vb_[NG];
#pragma unroll
          for (int n = 0; n < NG; ++n) { const size_t mo = ((size_t)db * 8 + cls + dil * (n0 + n)) * AW + co;
              ka[n] = *(const f32x4*)(p.out + O_KS + mo); kb[n] = *(const f32x4*)(p.out + O_KS + mo + 4); va[n] = *(const f32x4*)(p.out + O_VS + mo); vb_[n] = *(const f32x4*)(p.out + O_VS + mo + 4); }
          SBATCH(NG, 128 + n0, ka, kb, va, vb_); } }
#undef SBATCH
#undef SLOAD
    bf16* AP = (bf16*)(p.ws + WS_APART) + (size_t)br * MT * AW; float* L = (float*)(p.ws + WS_LSE) + (size_t)br * MT * 8;
#pragma unroll
    for (int qi = 0; qi < NQ; ++qi) { const size_t m = (size_t)NP + db * 8 + cls + dil * (Q0 + qi); const float rl = 1.0f / l[qi];
        v4u w; w.x = cvt_pk_bf16(o[qi][0] * rl, o[qi][1] * rl); w.y = cvt_pk_bf16(o[qi][2] * rl, o[qi][3] * rl); w.z = cvt_pk_bf16(o[qi][4] * rl, o[qi][5] * rl); w.w = cvt_pk_bf16(o[qi][6] * rl, o[qi][7] * rl);
        *(v4u*)(AP + m * AW + co) = w;
        if (c8 == 0) L[m * 8 + h] = mx[qi] + __builtin_amdgcn_logf(l[qi]); }
}
#ifndef RB4
#define RB4 2
#endif
#ifndef RB2
#define RB2 2
#endif
#ifndef RB1
#define RB1 4
#endif
constexpr int NTS5 = NDB * 14, NTC5 = NDB * 32;
__device__ __forceinline__ void p5_task(const KP& p, int tk, int lane) {
    if (tk < NTS5) { const int s = tk / NDB, db = tk % NDB;
#ifndef NO_T0
        if (s == 0) attn_sample_stream<4, 0, RB4>(p, db, 0, 1, 0, lane);
#endif
#ifndef NO_T1
        if (s == 1) attn_sample_stream<4, 4, RB4>(p, db, 0, 1, 0, lane);
#endif
#ifndef NO_T2
        if (s >= 2 && s < 6) attn_sample_stream<2, 0, RB2>(p, db, 1, 4, s - 2, lane);
#endif
#ifndef NO_T3
        if (s >= 6) attn_sample_stream<1, 0, RB1>(p, db, 2, 16, s - 6, lane);
#endif
    } else {
#ifndef NO_T4
        scan_sample_task(p, tk - NTS5, lane);
#endif
    }
}

__device__ __forceinline__ void combine_rows(const KP& p, int vcu, int G, int tid) {
    const int wave = __builtin_amdgcn_readfirstlane(tid >> 6), lane = tid & 63, gw = vcu * NWAVES + wave, NGW = G * NWAVES;
    const int h = lane >> 3, c8 = lane & 7, co = h * HD + 8 * c8;
    const bf16* AP = (const bf16*)(p.ws + WS_APART); const float* L = (const float*)(p.ws + WS_LSE);
    const float* VLi = (const float*)(p.ws + WS_VL); const float* SO = (const float*)(p.ws + WS_SOUT); const float* Gi = (const float*)(p.ws + WS_G); const float* BON = (const float*)(p.ws + WS_BON);
    const float* lg = p.in[23]; const float* lb = p.in[24];
    bf16* MIX = (bf16*)(p.ws + WS_MIX);
    const f32x4 g0 = *(const f32x4*)(lg + co), g1 = *(const f32x4*)(lg + co + 4), b0 = *(const f32x4*)(lb + co), b1 = *(const f32x4*)(lb + co + 4);
    for (int m = gw; m < MT; m += NGW) {
        const float l0 = L[(size_t)m * 8 + h], l1 = L[((size_t)MT + m) * 8 + h], l2 = L[((size_t)2 * MT + m) * 8 + h];
        const float lm = fmaxf(l0, fmaxf(l1, l2));
        float w0 = __builtin_amdgcn_exp2f(l0 - lm), w1 = __builtin_amdgcn_exp2f(l1 - lm), w2 = __builtin_amdgcn_exp2f(l2 - lm); const float ws_ = 1.0f / (w0 + w1 + w2); w0 *= ws_; w1 *= ws_; w2 *= ws_;
        const v4u a0 = *(const v4u*)(AP + (size_t)m * AW + co), a1 = *(const v4u*)(AP + ((size_t)MT + m) * AW + co), a2 = *(const v4u*)(AP + ((size_t)2 * MT + m) * AW + co);
        float at[8];
#pragma unroll
        for (int e = 0; e < 4; ++e) { at[2 * e] = w0 * bf2f(a0[e] & 0xffff) + w1 * bf2f(a1[e] & 0xffff) + w2 * bf2f(a2[e] & 0xffff); at[2 * e + 1] = w0 * bf2f(a0[e] >> 16) + w1 * bf2f(a1[e] >> 16) + w2 * bf2f(a2[e] >> 16); }
        v4u wo; wo.x = cvt_pk_bf16(at[0], at[1]); wo.y = cvt_pk_bf16(at[2], at[3]); wo.z = cvt_pk_bf16(at[4], at[5]); wo.w = cvt_pk_bf16(at[6], at[7]);
        *(v4u*)(MIX + (size_t)m * DM + co) = wo;
        const f32x4 o0 = *(const f32x4*)(SO + (size_t)m * AW + co), o1 = *(const f32x4*)(SO + (size_t)m * AW + co + 4);
        const float mean = sum8((o0.x + o0.y) + (o0.z + o0.w) + (o1.x + o1.y) + (o1.z + o1.w)) * (1.0f / 64.0f);
        const f32x4 d0 = o0 - mean, d1 = o1 - mean;
        const float var = sum8((d0.x * d0.x + d0.y * d0.y) + (d0.z * d0.z + d0.w * d0.w) + (d1.x * d1.x + d1.y * d1.y) + (d1.z * d1.z + d1.w * d1.w)) * (1.0f / 64.0f);
        const float rs = 1.0f / sqrtf(var + LNX_EPS);
        const f32x4 v0 = *(const f32x4*)(VLi + (size_t)m * AW + co), v1 = *(const f32x4*)(VLi + (size_t)m * AW + co + 4);
        const float bon = BON[(size_t)m * 8 + h];
        const f32x4 gg0 = *(const f32x4*)(Gi + (size_t)m * AW + co), gg1 = *(const f32x4*)(Gi + (size_t)m * AW + co + 4);
        const f32x4 y0 = (d0 * rs * g0 + b0 + v0 * bon) * gg0, y1 = (d1 * rs * g1 + b1 + v1 * bon) * gg1;
        v4u wr_; wr_.x = cvt_pk_bf16(y0.x, y0.y); wr_.y = cvt_pk_bf16(y0.z, y0.w); wr_.z = cvt_pk_bf16(y1.x, y1.y); wr_.w = cvt_pk_bf16(y1.z, y1.w);
        *(v4u*)(MIX + (size_t)m * DM + AW + co) = wr_;
    }
}

#ifndef REP0
#define REP0 1
#endif
#ifndef REP1
#define REP1 1
#endif
#ifndef REP2
#define REP2 1
#endif
#ifndef REP3
#define REP3 1
#endif
#ifndef REP4
#define REP4 1
#endif
#ifndef REP5
#define REP5 1
#endif
#ifndef REP6
#define REP6 1
#endif
#ifndef REP7
#define REP7 1
#endif
#ifndef REP8
#define REP8 1
#endif
#ifndef REP9
#define REP9 1
#endif
#ifndef REP10
#define REP10 1
#endif
#ifndef REP11
#define REP11 1
#endif
#ifndef REPA
#define REPA 1
#endif
#ifndef REPP
#define REPP 1
#endif
#ifndef TPROBE
#define TPROBE -1
#endif
#ifndef TAMP
#define TAMP 8
#endif
#ifndef PHM
#define PHM 0xFFF
#endif
#define PH(k) if constexpr (((PHM) >> (k)) & 1)
__global__ void __launch_bounds__(NWAVES * 64, 2) hybrid_fwd(KP p) {
    extern __shared__ __attribute__((aligned(16))) unsigned char lds_raw[];
    LAS unsigned char* lds = (LAS unsigned char*)lds_raw;
    volatile LAS unsigned* MISC = (volatile LAS unsigned*)(lds + MISC_OFF);
    const int tid0 = threadIdx.x;
    const int G = gridDim.x; int vcu; { const int bx = blockIdx.x; vcu = (G % 8 == 0) ? (bx % 8) * (G / 8) + bx / 8 : bx; }
    for (int u = tid0; u < (LDS_BYTES - LDSCTL_OFF) / 4; u += NWAVES * 64) ((LAS unsigned*)(lds + LDSCTL_OFF))[u] = 0u;
    __syncthreads();
#if TPROBE >= 0
    unsigned long long tst_[13]; int nst_ = 0; unsigned long long sub_[5] = {0, 0, 0, 0, 0};
    tst_[0] = __builtin_amdgcn_s_memrealtime();
#define SUBSTAMP(i) do { sub_[i] = __builtin_amdgcn_s_memrealtime(); } while (0)
#define TSTAMP() do { tst_[++nst_] = __builtin_amdgcn_s_memrealtime(); } while (0)
#else
#define TSTAMP() do {} while (0)
#define SUBSTAMP(i) do {} while (0)
#endif
    XcdBarrier bar = xcd_barrier_post((unsigned*)(p.ws + WS_CTL) + CW_BAR, MISC + 8);
    const int NGW = G * NWAVES;
    float* mod = (float*)(p.ws + WS_MOD);
#define PHASE_IDS int tid = threadIdx.x; asm volatile("" : "+v"(tid)); const int lane = tid & 63, wave = __builtin_amdgcn_readfirstlane(tid >> 6), gw = vcu * NWAVES + wave; (void)lane; (void)gw;

    _Pragma("unroll") for (int rep_ = 0; rep_ < REP0; ++rep_) { PHASE_IDS
    PH(0) p0_prologue(p, lds, vcu, G, tid);
    xcd_barrier(bar); TSTAMP();
    }
    _Pragma("unroll") for (int rep_ = 0; rep_ < REP1; ++rep_) { PHASE_IDS
    PH(1) { pg8::Gemm g{(const pg8::bf16_t*)(p.ws + WS_SILU), (const pg8::bf16_t*)(p.ws + WS_WADA), 256, MODW, DM, DM}; pg8::StaticOrder S; S.init(256, MODW, G, (int)blockIdx.x);
      pg8::EpiAda E{mod, MODW, p.in[11]};
      pg8::gemm_phase<pg8::EpiAda, pg8::StaticOrder, false, true>(lds + RING_OFF, g, S, E); }
    xcd_barrier(bar); TSTAMP();
    }
    _Pragma("unroll") for (int rep_ = 0; rep_ < REP2; ++rep_) { PHASE_IDS
    PH(2) norm_mod_rows(p.in[0], p.in[1], p.in[8], mod, 0, 1024, (bf16*)(p.ws + WS_H), vcu, G, tid);
    xcd_barrier(bar); TSTAMP();
    }
    _Pragma("unroll") for (int rep_ = 0; rep_ < REP3; ++rep_) { PHASE_IDS
    PH(3) { pg8::Gemm g{(const pg8::bf16_t*)(p.ws + WS_H), (const pg8::bf16_t*)(p.ws + WS_WIN), MT, INW, DM, DM}; pg8::StaticOrder S; S.init(MT, INW, G, (int)blockIdx.x);
      static_assert(WS_K - WS_Q == WS_V - WS_K, "q/k/v buffers equally spaced");
      pg8::EpiProj E{(pg8::bf16_t*)(p.ws + WS_Q), (WS_K - WS_Q) / 2, (float*)(p.ws + WS_P), (const float*)(p.ws + WS_ROPE),
                     p.out, O_KP, O_VP - O_KP, O_KS, O_VS - O_KS, p.out + O_SHP, p.out + O_SHS, QC2};
      pg8::gemm_phase<pg8::EpiProj, pg8::StaticOrder, true, true>(lds + RING_OFF, g, S, E); }
    xcd_barrier(bar); TSTAMP();
    }
    _Pragma("unroll") for (int rep_ = 0; rep_ < REP4; ++rep_) { PHASE_IDS
    PH(4) { LAS unsigned char* wl = lds + RING_OFF + wave * 16384;
      constexpr int NTA = 64 * 192, NTP = NT_PREP;
#define QUEUE_LOOP(QI, NTASK, CALL) do { constexpr int per_ = ((NTASK) + 255) / 256; LAS unsigned* qc_ = (LAS unsigned*)(lds + LDSCTL_OFF + 128 + 4 * (QI)); \
          _Pragma("unroll 1") for (;;) { int li_ = 0; if (lane == 0) li_ = (int)__hip_atomic_fetch_add(qc_, 1u, __ATOMIC_RELAXED, __HIP_MEMORY_SCOPE_WORKGROUP); li_ = __builtin_amdgcn_readfirstlane(li_); \
              const int sl_ = vcu + (li_ / per_) * G; if (sl_ >= 256) break; const int tk = sl_ * per_ + (li_ % per_); if (tk >= (NTASK)) continue; CALL; } } while (0)
      __syncthreads();
      if (tid < 8) ((LAS unsigned*)(lds + LDSCTL_OFF + 128))[tid] = 0u;
      __syncthreads();
      QUEUE_LOOP(0, 8 * NTG, prep_a_task(p, tk >> 3, tk & 7, wl, lane));
      QUEUE_LOOP(1, NTA, attn_prompt_task(p, tk, wl, lane));
      SUBSTAMP(2);
      QUEUE_LOOP(2, 4 * NTG, prep_w_task(p, tk >> 2, tk & 3, lane));
      SUBSTAMP(3);
      QUEUE_LOOP(3, 4 * NTG, prep_g_task(p, tk >> 2, tk & 3, lane));
      SUBSTAMP(4);
    }
    xcd_barrier(bar); TSTAMP();
    }
    _Pragma("unroll") for (int rep_ = 0; rep_ < REP5; ++rep_) { PHASE_IDS
    PH(5) {
      const unsigned sw = (unsigned)(uintptr_t)(lds + LDSCTL_OFF);
      __syncthreads();
      if (tid < 40) lds_st(sw + 4 * tid, 0u);
      asm volatile("s_waitcnt lgkmcnt(0)" ::: "memory");
      __syncthreads();
      SUBSTAMP(0);
#ifndef NO_SB
      if (wave < 5) scan_block(p, lds + RING_OFF, sw, wave, lane, G, vcu);
#endif
      SUBSTAMP(1);
      { LAS unsigned* qc_ = (LAS unsigned*)(lds + LDSCTL_OFF + 128);
        constexpr int PA = (NTS5 + 255) / 256, PS = (NTC5 + 255) / 256;
#pragma unroll 1
        for (;;) { int li = 0; if (lane == 0) li = (int)__hip_atomic_fetch_add(qc_, 1u, __ATOMIC_RELAXED, __HIP_MEMORY_SCOPE_WORKGROUP); li = __builtin_amdgcn_readfirstlane(li);
            const int sl = vcu + (li / (PA + PS)) * G, r = li % (PA + PS); if (sl >= 256) break;
            const int tk = r < PA ? sl * PA + r : NTS5 + sl * PS + (r - PA);
            if (r < PA ? tk < NTS5 : tk < NTS5 + NTC5) p5_task(p, tk, lane); } }
    }
    xcd_barrier(bar); TSTAMP();
    }
    _Pragma("unroll") for (int rep_ = 0; rep_ < REP6; ++rep_) { PHASE_IDS
    PH(6) combine_rows(p, vcu, G, tid);
    xcd_barrier(bar); TSTAMP();
    }
    _Pragma("unroll") for (int rep_ = 0; rep_ < REP7; ++rep_) { PHASE_IDS
    PH(7) { pg8::EpiRes E{p.in[0], p.in[1], NP, (float*)(p.ws + WS_X1), DM, mod + 2048, MODW, (float*)(p.ws + WS_PART), DM / SK_OUT};
      { pg8::Gemm g{(const pg8::bf16_t*)(p.ws + WS_MIX), (const pg8::bf16_t*)(p.ws + WS_WOUT), NP, DM, DM, DM}; pg8::StaticOrder S; S.init(NP, DM, G, (int)blockIdx.x);
        pg8::gemm_phase<pg8::EpiRes, pg8::StaticOrder, true, true>(lds + RING_OFF, g, S, E); }
      { pg8::Gemm g{(const pg8::bf16_t*)(p.ws + WS_MIX), (const pg8::bf16_t*)(p.ws + WS_WOUT), MT, DM, DM / SK_OUT, DM}; pg8::SplitOrder S; S.init(NP / 256, NSM / 256, DM, SK_OUT, DM / SK_OUT, G, (int)blockIdx.x);
        pg8::gemm_phase<pg8::EpiRes, pg8::SplitOrder, true, true>(lds + RING_OFF, g, S, E); } }
    xcd_barrier(bar); TSTAMP();
    }
    _Pragma("unroll") for (int rep_ = 0; rep_ < REP8; ++rep_) { PHASE_IDS
    PH(8) norm_mod_rows((const float*)(p.ws + WS_X1), (const float*)(p.ws + WS_X1) + (size_t)NP * DM, p.in[9], mod, 3072, 4096, (bf16*)(p.ws + WS_H), vcu, G, tid, (const float*)(p.ws + WS_PART), SK_OUT - 1, (float*)(p.ws + WS_X1) + (size_t)NP * DM);
    xcd_barrier(bar); TSTAMP();
    }
    _Pragma("unroll") for (int rep_ = 0; rep_ < REP9; ++rep_) { PHASE_IDS
    PH(9) { pg8::Gemm g{(const pg8::bf16_t*)(p.ws + WS_H), (const pg8::bf16_t*)(p.ws + WS_WFF1), MT, DFF, DM, DM}; pg8::StaticOrder S; S.init(MT, DFF, G, (int)blockIdx.x);
      pg8::EpiRelu2 E{(pg8::bf16_t*)(p.ws + WS_U), DFF};
      pg8::gemm_phase<pg8::EpiRelu2, pg8::StaticOrder, true, true>(lds + RING_OFF, g, S, E); }
    xcd_barrier(bar); TSTAMP();
    }
    _Pragma("unroll") for (int rep_ = 0; rep_ < REP10; ++rep_) { PHASE_IDS
    PH(10) { pg8::EpiRes E{(const float*)(p.ws + WS_X1), (const float*)(p.ws + WS_X1) + (size_t)NP * DM, NP, (float*)(p.ws + WS_X2), DM, mod + 5120, MODW, (float*)(p.ws + WS_PART), DFF / SK_FF2};
      { pg8::Gemm g{(const pg8::bf16_t*)(p.ws + WS_U), (const pg8::bf16_t*)(p.ws + WS_WFF2), NP, DM, DFF, DFF}; pg8::StaticOrder S; S.init(NP, DM, G, (int)blockIdx.x);
        pg8::gemm_phase<pg8::EpiRes, pg8::StaticOrder, true, true>(lds + RING_OFF, g, S, E); }
      { pg8::Gemm g{(const pg8::bf16_t*)(p.ws + WS_U), (const pg8::bf16_t*)(p.ws + WS_WFF2), MT, DM, DFF / SK_FF2, DFF}; pg8::SplitOrder S; S.init(NP / 256, NSM / 256, DM, SK_FF2, DFF / SK_FF2, G, (int)blockIdx.x);
        pg8::gemm_phase<pg8::EpiRes, pg8::SplitOrder, true, true>(lds + RING_OFF, g, S, E); } }
    xcd_barrier(bar); TSTAMP();
    }
    _Pragma("unroll") for (int rep_ = 0; rep_ < REP11; ++rep_) { PHASE_IDS
    PH(11) final_norm_rows((const float*)(p.ws + WS_X2), p.in[27], p.out + O_YP, vcu, G, tid, (const float*)(p.ws + WS_PART), SK_FF2 - 1);
    if (rep_ + 1 < REP11) xcd_barrier(bar);
    }
#if TPROBE >= 0
    __syncthreads(); TSTAMP();
    if (blockIdx.x == 0 && threadIdx.x == 0) {
#ifdef TSUB
        const unsigned long long dt = (sub_[TSUB + 1] - sub_[TSUB]) * (unsigned long long)(TAMP);
#else
        const unsigned long long dt = (tst_[TPROBE + 1] - tst_[TPROBE]) * (unsigned long long)(TAMP);
#endif
         const unsigned long long t0 = __builtin_amdgcn_s_memrealtime();
        while (__builtin_amdgcn_s_memrealtime() - t0 < dt) __builtin_amdgcn_s_sleep(8); }
#endif
}

extern "C" void kernel_launch(void* const* d_in, const int* in_sizes, int n_in, void* d_out, int out_size, void* d_ws, size_t ws_size, hipStream_t stream) {
    static int grid = 0;
    if (grid == 0) {
        if (n_in != 28 || (size_t)out_size != O_END || ws_size < WS_END) { fprintf(stderr, "kernel_launch: unexpected shapes (n_in %d out %d ws %zu)\n", n_in, out_size, ws_size); grid = -1; return; }
        int dev = 0, cus = 0, per_cu = 0;
        if (hipGetDevice(&dev) != hipSuccess || hipDeviceGetAttribute(&cus, hipDeviceAttributeMultiprocessorCount, dev) != hipSuccess) { grid = -1; return; }
        if (hipFuncSetAttribute((const void*)hybrid_fwd, hipFuncAttributeMaxDynamicSharedMemorySize, LDS_BYTES) != hipSuccess) { fprintf(stderr, "kernel_launch: hipFuncSetAttribute failed\n"); grid = -1; return; }
        if (hipOccupancyMaxActiveBlocksPerMultiprocessor(&per_cu, (const void*)hybrid_fwd, NWAVES * 64, LDS_BYTES) != hipSuccess || per_cu < 1) fprintf(stderr, "kernel_launch: occupancy query reports %d\n", per_cu);
        (void)hipGetLastError();
        grid = cus;
    }
    if (grid < 0) return;
    if (hipMemsetAsync((char*)d_ws + WS_CTL, 0, CTL_ZERO_BYTES, stream) != hipSuccess) return;
    KP a{};
    for (int i = 0; i < 28; ++i) a.in[i] = (const float*)d_in[i];
    a.out = (float*)d_out; a.ws = (unsigned char*)d_ws;
    hipLaunchKernelGGL(hybrid_fwd, dim3(grid), dim3(NWAVES * 64), LDS_BYTES, stream, a);
}
```
